# Optimizing an MI355X kernel written in HIP

```python
import jax
import jax.numpy as jnp
from jax import lax
import numpy as np

D_MODEL = 1024
BATCH = 8
SEQ = 4096
DEPTH = 4

GRID_W = 64
CTX_LEN = 256
N_HEADS = 4
D_INNER = 2 * D_MODEL
HEAD_V = D_INNER // N_HEADS
MLSTM_QK = D_MODEL
MLSTM_HEAD_QK = MLSTM_QK // N_HEADS
CONV_K = 3
GLA_KEY = D_MODEL // 2
GLA_HEAD_K = GLA_KEY // N_HEADS
GLA_RANK = 16
GLA_TAU = 16.0
RET_KEY = D_MODEL
RET_HEAD_K = RET_KEY // N_HEADS
ROPE_BASE = 10000.0
CHUNK = 64
NORM_EPS = 1e-6
NEG_INF = -1e30
MIXERS = ('mlstm', 'gla', 'retention')
MLSTM_IN = 2 * MLSTM_QK + 2 * D_INNER + 4 * N_HEADS
GLA_IN = 2 * GLA_KEY + 2 * D_INNER + 2 * GLA_RANK
RET_IN = 2 * RET_KEY + 2 * D_INNER

kernel_name = 'hybrid_mlstm_gla_retention_prefix_dit'


def rmsnorm(x, w):
    xf = x.astype(jnp.float32)
    y = xf * lax.rsqrt(jnp.mean(xf * xf, axis=-1, keepdims=True) + NORM_EPS)
    return (y * w.astype(jnp.float32)).astype(x.dtype)


def head_norm(y, w, center):
    if center:
        y = y - jnp.mean(y, axis=-1, keepdims=True)
    y = y * lax.rsqrt(jnp.mean(y * y, axis=-1, keepdims=True) + NORM_EPS)
    return y.reshape(y.shape[:2] + (-1,)) * w.astype(jnp.float32)


def flip_parts(t, n_ctx):
    return jnp.concatenate([jnp.flip(t[:, :n_ctx], axis=1), jnp.flip(t[:, n_ctx:], axis=1)], axis=1)


def to_chunks(t):
    b, l = t.shape[:2]
    return jnp.moveaxis(t.reshape((b, l // CHUNK, CHUNK) + t.shape[2:]), 1, 0)


def from_chunks(t):
    t = jnp.moveaxis(t, 0, 1)
    return t.reshape((t.shape[0], -1) + t.shape[3:])


def mlstm_scan(q, k, v, log_i, log_f):
    b_, _, h_, dk = q.shape
    dv = v.shape[-1]
    tri = jnp.tril(jnp.ones((CHUNK, CHUNK), dtype=bool))

    def step(carry, inp):
        c_st, n_st, m_st = carry
        qc, kc, vc, ic, fc = inp
        ic = ic.transpose(0, 2, 1)
        b = jnp.cumsum(fc.transpose(0, 2, 1), axis=-1)
        d = jnp.where(tri, b[..., :, None] - b[..., None, :] + ic[..., None, :], NEG_INF)
        inter = b + m_st[..., None]
        m_row = jnp.maximum(inter, jnp.max(d, axis=-1))
        s = jnp.einsum('bjhd,blhd->bhjl', qc, kc) * jnp.exp(d - m_row[..., None])
        w_inter = jnp.exp(inter - m_row)
        numer = (jnp.einsum('bhjl,blhv->bjhv', s, vc)
                 + jnp.einsum('bjhd,bhdv->bjhv', qc, c_st) * w_inter.transpose(0, 2, 1)[..., None])
        denom = jnp.sum(s, axis=-1) + jnp.einsum('bjhd,bhd->bhj', qc, n_st) * w_inter
        floor = jnp.maximum(jnp.abs(denom), jnp.exp(-m_row))
        h = numer / floor.transpose(0, 2, 1)[..., None]
        b_end = b[..., -1]
        g = b_end[..., None] - b + ic
        m_new = jnp.maximum(b_end + m_st, jnp.max(g, axis=-1))
        decay = jnp.exp(b_end + m_st - m_new)
        wk = kc * jnp.exp(g - m_new[..., None]).transpose(0, 2, 1)[..., None]
        c_new = decay[..., None, None] * c_st + jnp.einsum('blhd,blhv->bhdv', wk, vc)
        n_new = decay[..., None] * n_st + jnp.sum(wk, axis=1)
        return (c_new, n_new, m_new), h

    init = (jnp.zeros((b_, h_, dk, dv), jnp.float32),
            jnp.zeros((b_, h_, dk), jnp.float32),
            jnp.zeros((b_, h_), jnp.float32))
    _, hs = lax.scan(step, init, (to_chunks(q), to_chunks(k), to_chunks(v), to_chunks(log_i), to_chunks(log_f)))
    return from_chunks(hs)


def decay_scan(q, k, v, log_a):
    b_, _, h_, dk = q.shape
    dv = v.shape[-1]
    per_channel = log_a.shape[-1] > 1
    tri = jnp.tril(jnp.ones((CHUNK, CHUNK), dtype=bool))

    def step(s_st, inp):
        qc, kc, vc, ac = inp
        b = jnp.cumsum(ac, axis=1)
        if per_channel:
            rel = jnp.where(tri[None, :, :, None, None], b[:, :, None] - b[:, None], NEG_INF)
            s = jnp.einsum('bjhd,blhd,bjlhd->bhjl', qc, kc, jnp.exp(rel))
        else:
            rel = jnp.where(tri[None, :, :, None], b[:, :, None, :, 0] - b[:, None, :, :, 0], NEG_INF)
            s = jnp.einsum('bjhd,blhd->bhjl', qc, kc) * jnp.exp(rel).transpose(0, 3, 1, 2)
        o = jnp.einsum('bhjl,blhv->bjhv', s, vc) + jnp.einsum('bjhd,bhdv->bjhv', qc * jnp.exp(b), s_st)
        b_end = b[:, -1:]
        s_new = (jnp.exp(b_end[:, 0])[..., None] * s_st
                 + jnp.einsum('blhd,blhv->bhdv', kc * jnp.exp(b_end - b), vc))
        return s_new, o

    init = jnp.zeros((b_, h_, dk, dv), jnp.float32)
    _, os_ = lax.scan(step, init, (to_chunks(q), to_chunks(k), to_chunks(v), to_chunks(log_a)))
    return from_chunks(os_)


def bidirectional(scan_fn, n_ctx, shared, fw, bw):
    out_fw = scan_fn(*shared, *fw)
    out_bw = scan_fn(*[flip_parts(t, n_ctx) for t in shared], *[flip_parts(t, n_ctx) for t in bw])
    return out_fw + flip_parts(out_bw, n_ctx)


def axial_rope(t):
    s, dh = t.shape[1], t.shape[-1]
    quarter = dh // 4
    pos = jnp.arange(s, dtype=jnp.int32)
    row = (pos // GRID_W).astype(jnp.float32)
    col = (pos % GRID_W).astype(jnp.float32)
    inv_freq = ROPE_BASE ** (-jnp.arange(quarter, dtype=jnp.float32) / quarter)

    def rot(u, p):
        ang = p[:, None] * inv_freq[None, :]
        cos = jnp.cos(ang)[None, :, None, :]
        sin = jnp.sin(ang)[None, :, None, :]
        u1, u2 = u[..., :quarter], u[..., quarter:]
        return jnp.concatenate([u1 * cos - u2 * sin, u1 * sin + u2 * cos], axis=-1)

    return jnp.concatenate([rot(t[..., :dh // 2], row), rot(t[..., dh // 2:], col)], axis=-1)


def grid_conv(u_ctx, u_lat, conv_w, conv_b):
    b, s, ch = u_lat.shape
    n_ctx = u_ctx.shape[1]
    rows = s // GRID_W
    lat = lax.conv_general_dilated(u_lat.reshape(b, rows, GRID_W, ch), conv_w[:, :, None, :],
                                   window_strides=(1, 1), padding='SAME',
                                   dimension_numbers=('NHWC', 'HWIO', 'NHWC'),
                                   feature_group_count=ch).reshape(b, s, ch)
    w1 = conv_w[CONV_K // 2]
    pad = jnp.pad(u_ctx, ((0, 0), (CONV_K // 2, CONV_K // 2), (0, 0)))
    ctx_out = sum(pad[:, i:i + n_ctx] * w1[i] for i in range(CONV_K))
    return jnp.concatenate([ctx_out, lat], axis=1) + conv_b


def mlstm_mixer(u, n_ctx, in_w, conv_w, conv_b, gate_b, head_norm_w):
    b, l, _ = u.shape
    p = u @ in_w
    qk, v, z, gates = jnp.split(p, [2 * MLSTM_QK, 2 * MLSTM_QK + D_INNER, 2 * MLSTM_QK + 2 * D_INNER], axis=-1)
    qk = jax.nn.silu(grid_conv(qk[:, :n_ctx], qk[:, n_ctx:], conv_w, conv_b))
    q, k = jnp.split(qk, 2, axis=-1)
    q = q.reshape(b, l, N_HEADS, MLSTM_HEAD_QK).astype(jnp.float32)
    k = k.reshape(b, l, N_HEADS, MLSTM_HEAD_QK).astype(jnp.float32) * (MLSTM_HEAD_QK ** -0.5)
    v = v.reshape(b, l, N_HEADS, HEAD_V).astype(jnp.float32)
    g = gates.astype(jnp.float32) + gate_b.astype(jnp.float32)
    i_fw, f_fw, i_bw, f_bw = jnp.split(g, 4, axis=-1)
    h = bidirectional(mlstm_scan, n_ctx, (q, k, v),
                      (i_fw, jax.nn.log_sigmoid(f_fw)), (i_bw, jax.nn.log_sigmoid(f_bw)))
    h = head_norm(h, head_norm_w, center=True)
    return (h * jax.nn.silu(z.astype(jnp.float32))).astype(u.dtype)


def gla_mixer(u, n_ctx, in_w, gk_w2, gk_b, head_norm_w):
    b, l, _ = u.shape
    p = u @ in_w
    q, k, v, z, lr = jnp.split(p, [GLA_KEY, 2 * GLA_KEY, 2 * GLA_KEY + D_INNER, 2 * GLA_KEY + 2 * D_INNER], axis=-1)
    q = q.reshape(b, l, N_HEADS, GLA_HEAD_K).astype(jnp.float32) * (GLA_HEAD_K ** -0.5)
    k = k.reshape(b, l, N_HEADS, GLA_HEAD_K).astype(jnp.float32)
    v = v.reshape(b, l, N_HEADS, HEAD_V).astype(jnp.float32)
    lr_fw, lr_bw = jnp.split(lr, 2, axis=-1)

    def log_alpha(code, w2, bias):
        pre = jnp.einsum('blr,rk->blk', code, w2).astype(jnp.float32) + bias.astype(jnp.float32)
        return (jax.nn.log_sigmoid(pre) / GLA_TAU).reshape(b, l, N_HEADS, GLA_HEAD_K)

    o = bidirectional(decay_scan, n_ctx, (q, k, v),
                      (log_alpha(lr_fw, gk_w2[0], gk_b[0]),), (log_alpha(lr_bw, gk_w2[1], gk_b[1]),))
    o = head_norm(o, head_norm_w, center=False)
    return (o * jax.nn.silu(z.astype(jnp.float32))).astype(u.dtype)


def retention_mixer(u, n_ctx, in_w, decay_logit, head_norm_w):
    b, l, _ = u.shape
    p = u @ in_w
    q, k, v, z = jnp.split(p, [RET_KEY, 2 * RET_KEY, 2 * RET_KEY + D_INNER], axis=-1)
    q = q.reshape(b, l, N_HEADS, RET_HEAD_K).astype(jnp.float32)
    k = k.reshape(b, l, N_HEADS, RET_HEAD_K).astype(jnp.float32)
    q = jnp.concatenate([q[:, :n_ctx], axial_rope(q[:, n_ctx:])], axis=1)
    k = jnp.concatenate([k[:, :n_ctx], axial_rope(k[:, n_ctx:])], axis=1) * (RET_HEAD_K ** -0.5)
    v = v.reshape(b, l, N_HEADS, HEAD_V).astype(jnp.float32)
    log_gamma = jax.nn.log_sigmoid(decay_logit.astype(jnp.float32))
    la_fw = jnp.broadcast_to(log_gamma[0][None, None, :, None], (b, l, N_HEADS, 1))
    la_bw = jnp.broadcast_to(log_gamma[1][None, None, :, None], (b, l, N_HEADS, 1))
    o = bidirectional(decay_scan, n_ctx, (q, k, v), (la_fw,), (la_bw,))
    o = head_norm(o, head_norm_w, center=True)
    return (o * jax.nn.silu(z.astype(jnp.float32))).astype(u.dtype)


def hybrid_layer(kind, ctx_h, lat_h, c, c_ctx, norm_w, ada_w, ada_b, out_w, mixer_params, last):
    n_ctx = ctx_h.shape[1]
    ada_lat = jax.nn.silu(c) @ ada_w + ada_b
    ada_ctx = jax.nn.silu(c_ctx) @ ada_w + ada_b
    sh_l, sc_l, g_l = jnp.split(ada_lat[:, None, :], 3, axis=-1)
    sh_c, sc_c, g_c = jnp.split(ada_ctx, 3, axis=-1)
    u = jnp.concatenate([rmsnorm(ctx_h, norm_w) * (1 + sc_c) + sh_c,
                         rmsnorm(lat_h, norm_w) * (1 + sc_l) + sh_l], axis=1)
    if kind == 'mlstm':
        y = mlstm_mixer(u, n_ctx, *mixer_params)
    elif kind == 'gla':
        y = gla_mixer(u, n_ctx, *mixer_params)
    else:
        y = retention_mixer(u, n_ctx, *mixer_params)
    lat_h = lat_h + g_l * (y[:, n_ctx:] @ out_w)
    if not last:
        ctx_h = ctx_h + g_c * (y[:, :n_ctx] @ out_w)
    return ctx_h, lat_h


def setup_inputs(seed: int = 0) -> dict:
    key = jax.random.key(seed)
    keys = iter(jax.random.split(key, 64))

    def rnd(shape, std):
        return std * jax.random.normal(next(keys), shape, jnp.float32)

    inputs = {
        'x': rnd((BATCH, SEQ, D_MODEL), 1.0),
        'c': rnd((BATCH, D_MODEL), 1.0),
        'ctx': rnd((BATCH, CTX_LEN, D_MODEL), 1.0),
        'c_ctx': rnd((D_MODEL,), 1.0),
    }
    for i in range(DEPTH):
        kind = MIXERS[i % len(MIXERS)]
        p = 'l%d_' % i
        inputs[p + 'norm_w'] = 1.0 + rnd((D_MODEL,), 0.1)
        inputs[p + 'ada_w'] = rnd((D_MODEL, 3 * D_MODEL), 0.5 * D_MODEL ** -0.5)
        inputs[p + 'ada_b'] = rnd((3 * D_MODEL,), 0.02)
        if kind == 'mlstm':
            inputs[p + 'in_w'] = rnd((D_MODEL, MLSTM_IN), D_MODEL ** -0.5)
            inputs[p + 'conv_w'] = rnd((CONV_K, CONV_K, 2 * MLSTM_QK), 1.0 / CONV_K)
            inputs[p + 'conv_b'] = rnd((2 * MLSTM_QK,), 0.02)
            f_bias = jnp.linspace(3.0, 6.0, N_HEADS, dtype=jnp.float32)
            inputs[p + 'gate_b'] = jnp.concatenate([rnd((N_HEADS,), 0.1), f_bias + rnd((N_HEADS,), 0.1),
                                                    rnd((N_HEADS,), 0.1), f_bias + rnd((N_HEADS,), 0.1)])
        elif kind == 'gla':
            inputs[p + 'in_w'] = rnd((D_MODEL, GLA_IN), D_MODEL ** -0.5)
            inputs[p + 'gk_w2'] = rnd((2, GLA_RANK, GLA_KEY), GLA_RANK ** -0.5)
            inputs[p + 'gk_b'] = rnd((2, GLA_KEY), 0.5)
        else:
            inputs[p + 'in_w'] = rnd((D_MODEL, RET_IN), D_MODEL ** -0.5)
            p_decay = 2.0 ** (-5.0 - jnp.arange(N_HEADS, dtype=jnp.float32))
            inputs[p + 'decay_logit'] = (jnp.log1p(-p_decay) - jnp.log(p_decay))[None, :] + rnd((2, N_HEADS), 0.1)
        inputs[p + 'head_norm_w'] = 1.0 + rnd((D_INNER,), 0.1)
        inputs[p + 'out_w'] = rnd((D_INNER, D_MODEL), D_INNER ** -0.5)
    inputs['final_norm_w'] = 1.0 + rnd((D_MODEL,), 0.1)
    return inputs


def reference(x, c, ctx, c_ctx,
              l0_norm_w, l0_ada_w, l0_ada_b, l0_in_w, l0_conv_w, l0_conv_b, l0_gate_b, l0_head_norm_w, l0_out_w,
              l1_norm_w, l1_ada_w, l1_ada_b, l1_in_w, l1_gk_w2, l1_gk_b, l1_head_norm_w, l1_out_w,
              l2_norm_w, l2_ada_w, l2_ada_b, l2_in_w, l2_decay_logit, l2_head_norm_w, l2_out_w,
              l3_norm_w, l3_ada_w, l3_ada_b, l3_in_w, l3_conv_w, l3_conv_b, l3_gate_b, l3_head_norm_w, l3_out_w,
              final_norm_w):
    layers = (
        ('mlstm', l0_norm_w, l0_ada_w, l0_ada_b, l0_out_w,
         (l0_in_w, l0_conv_w, l0_conv_b, l0_gate_b, l0_head_norm_w)),
        ('gla', l1_norm_w, l1_ada_w, l1_ada_b, l1_out_w,
         (l1_in_w, l1_gk_w2, l1_gk_b, l1_head_norm_w)),
        ('retention', l2_norm_w, l2_ada_w, l2_ada_b, l2_out_w,
         (l2_in_w, l2_decay_logit, l2_head_norm_w)),
        ('mlstm', l3_norm_w, l3_ada_w, l3_ada_b, l3_out_w,
         (l3_in_w, l3_conv_w, l3_conv_b, l3_gate_b, l3_head_norm_w)),
    )
    ctx_h, lat_h = ctx, x
    for i in range(DEPTH):
        kind, norm_w, ada_w, ada_b, out_w, mixer_params = layers[i]
        ctx_h, lat_h = hybrid_layer(kind, ctx_h, lat_h, c, c_ctx, norm_w, ada_w, ada_b, out_w,
                                    mixer_params, last=(i == DEPTH - 1))
    return rmsnorm(lat_h, final_norm_w)
```

```cpp
#include <hip/hip_runtime.h>
#include <hip/hip_cooperative_groups.h>
#include <cstdio>
namespace cg = cooperative_groups;

#define LAS __attribute__((address_space(3)))
#define DI __device__ __forceinline__
typedef unsigned short bf16_t;
typedef short bf16x8 __attribute__((ext_vector_type(8)));
typedef short s16x4 __attribute__((ext_vector_type(4)));
typedef float f32x4 __attribute__((ext_vector_type(4)));
typedef float f32x2 __attribute__((ext_vector_type(2)));
typedef unsigned u32x4 __attribute__((ext_vector_type(4)));
typedef unsigned u32x2 __attribute__((ext_vector_type(2)));
typedef __bf16 bfv2 __attribute__((ext_vector_type(2)));
typedef LAS unsigned char* lds_t;

constexpr int MTOK = 34816, LTOK = 4352, NCHK = 68;
constexpr size_t SZ_BIG = (size_t)MTOK * 2048 * 2;
constexpr size_t OFF_R0 = 0;
constexpr size_t OFF_RO = SZ_BIG;
constexpr size_t OFF_RQ = 2 * SZ_BIG;
constexpr size_t OFF_RK = OFF_RQ + SZ_BIG / 2;
constexpr size_t OFF_RS = OFF_RK + SZ_BIG / 2;
constexpr size_t SZ_S = (size_t)2 * 8 * 4 * 68 * 4096 * 2;
constexpr size_t OFF_HCTX = OFF_RS + SZ_S;
constexpr size_t OFF_WT = OFF_HCTX + (size_t)8 * 256 * 1024 * 4;
constexpr size_t OFF_WO = OFF_WT + (size_t)6144 * 1024 * 2;
constexpr size_t OFF_GATES = OFF_WO + (size_t)1024 * 2048 * 2;
constexpr size_t SZ_SCAL = (size_t)2 * 8 * 4 * LTOK * 4;
constexpr size_t OFF_SA = OFF_GATES + (size_t)MTOK * 32 * 4;
constexpr size_t OFF_SC = OFF_SA + SZ_SCAL;
constexpr size_t OFF_SR = OFF_SC + SZ_SCAL;
constexpr size_t OFF_SF = OFF_SR + SZ_SCAL;
constexpr size_t OFF_SK = OFF_SF + SZ_SCAL;
constexpr size_t OFF_RSUM = OFF_SK + SZ_SCAL;
constexpr size_t OFF_DECS = OFF_RSUM + SZ_SCAL;
constexpr size_t OFF_DEC = OFF_DECS + 32768;
constexpr size_t OFF_ADA = OFF_DEC + (size_t)2 * 8 * 4 * 68 * 128 * 4;
constexpr size_t OFF_OCB = OFF_ADA + (size_t)4 * 9 * 3072 * 4;
constexpr size_t OFF_TAB = OFF_OCB + (size_t)8 * 256 * 2048 * 2;
constexpr size_t OFF_BAR = OFF_TAB + 4096;
constexpr size_t OFF_STATS = OFF_BAR + 16384;
constexpr size_t OFF_WT2 = OFF_STATS + (size_t)MTOK * 4 * 8;
constexpr size_t OFF_WO2 = OFF_WT2 + (size_t)6144 * 1024 * 2;
constexpr size_t WS_END = OFF_WO2 + (size_t)1024 * 2048 * 2;
constexpr int LDS_BYTES = 147456;

#ifndef REP_GEMM
#define REP_GEMM 1
#endif
#ifndef REP_SCAN
#define REP_SCAN 1
#endif
#ifndef REP_P3
#define REP_P3 1
#endif
#ifndef REP_SYNC
#define REP_SYNC 0
#endif
#ifndef REP_P5D
#define REP_P5D 0
#endif
#ifndef REP_OUTD
#define REP_OUTD 0
#endif
#ifndef REP_P0
#define REP_P0 1
#endif
#ifndef REP_P1F
#define REP_P1F 1
#endif
#ifndef REP_P1
#define REP_P1 1
#endif
struct Params { const float* in[38]; float* out; unsigned char* ws; };

DI int otid() { int t = threadIdx.x; asm volatile("" : "+v"(t)); return t; }
DI int obid() { int t = blockIdx.x; asm volatile("" : "+s"(t)); return t; }
struct PP { float* out; unsigned char* ws; };
DI PP launder(const Params& p) { PP q; q.out = p.out; q.ws = p.ws; asm volatile("" : "+s"(q.out), "+s"(q.ws)); return q; }
DI PP launder(const PP& p) { PP q = p; asm volatile("" : "+s"(q.out), "+s"(q.ws)); return q; }
DI size_t off_wt(int l) { return (l & 1) ? OFF_WT2 : OFF_WT; }
DI size_t off_wo(int l) { return (l & 1) ? OFF_WO2 : OFF_WO; }
DI const float* tin(const PP& p, int i) { return ((const float* const*)(p.ws + OFF_TAB))[i]; }
DI float bf2f(unsigned b) { return __uint_as_float(b << 16); }
DI unsigned pack2(float a, float b) { f32x2 f = {a, b}; bfv2 r = __builtin_convertvector(f, bfv2); return __builtin_bit_cast(unsigned, r); }
DI bf16_t f2bf(float a) { return (bf16_t)(pack2(a, 0.f) & 0xffffu); }
DI float lo_f(unsigned w) { return __uint_as_float(w << 16); }
DI float hi_f(unsigned w) { return __uint_as_float(w & 0xffff0000u); }
DI float dot2(unsigned a, unsigned b, float c) { return __builtin_amdgcn_fdot2_f32_bf16(__builtin_bit_cast(bfv2, a), __builtin_bit_cast(bfv2, b), c, false); }
DI float siluf(float v) { return v / (1.f + __expf(-v)); }
DI float logsig(float x) { return fminf(x, 0.f) - __logf(1.f + __expf(-fabsf(x))); }
DI int lbase(int l) { return l == 0 ? 4 : (l == 1 ? 13 : (l == 2 ? 21 : 28)); }
DI int lkind(int l) { return l == 1 ? 1 : (l == 2 ? 2 : 0); }
DI float shx(float v, int mask, int lane) { return __int_as_float(__builtin_amdgcn_ds_bpermute((lane ^ mask) << 2, __float_as_int(v))); }
DI float shup(float v, int o, int lane) { return __int_as_float(__builtin_amdgcn_ds_bpermute((lane - o) << 2, __float_as_int(v))); }
DI float wsum(float v, int lane) {
#pragma unroll
    for (int o = 32; o >= 1; o >>= 1) v += shx(v, o, lane);
    return v; }
DI const float* hrow(const PP& p, int row, int l) {
    const int b = row / LTOK, t = row - b * LTOK;
    if (l == 0) return t < 256 ? tin(p, 2) + (size_t)(b * 256 + t) * 1024 : tin(p, 0) + (size_t)(b * 4096 + t - 256) * 1024;
    return t < 256 ? (const float*)(p.ws + OFF_HCTX) + (size_t)(b * 256 + t) * 1024 : p.out + (size_t)(b * 4096 + t - 256) * 1024;
}

#define XB_TMO      128
#define XB_XCNT(j)  (256  + 64 * (j))
#define XB_XSUB(j)  (1280 + 64 * (j))
#define XB_XGEN(j)  (2304 + 64 * (j))
#define XB_TOP      3328
#define XB_TOPGEN   3392
#define XCD_BAR_WORDS 3456
#define XB_SPIN_CAP (1u << 22)
DI unsigned xb_ld(unsigned* p)              { return __hip_atomic_load(p, __ATOMIC_RELAXED, __HIP_MEMORY_SCOPE_AGENT); }
DI unsigned xb_add(unsigned* p, unsigned v) { return __hip_atomic_fetch_add(p, v, __ATOMIC_RELAXED, __HIP_MEMORY_SCOPE_AGENT); }
DI unsigned xb_xcc_id() { return (unsigned)__builtin_amdgcn_s_getreg((3 << 11) | 20) & 0xFu; }
#define XB_SPIN(cond, bar) do { unsigned _sp = 0; while (cond) { __builtin_amdgcn_s_sleep(1); \
    if ((++_sp & 255u) == 0u) { if (xb_ld(&(bar)[XB_TMO])) break; if (_sp > XB_SPIN_CAP) { atomicAdd(&(bar)[XB_TMO], 1u); break; } } } } while (0)
struct XcdBarrier { unsigned* bar; unsigned x; volatile LAS unsigned* st; };
DI XcdBarrier xcd_barrier_post(unsigned* bar, volatile LAS unsigned* st) {
    XcdBarrier b; b.bar = bar; b.x = xb_xcc_id(); b.st = st;
    if (threadIdx.x == 0) (void)xb_add(&bar[XB_XCNT(b.x)], 1u);
    return b;
}
DI void xcd_barrier_complete(unsigned* bar, unsigned x, unsigned& nloc, unsigned& nx) {
    const unsigned G = gridDim.x * gridDim.y * gridDim.z;
    unsigned sum, cnt, mine, sp = 0u;
    for (;;) {
        sum = 0u; cnt = 0u; mine = 0u;
#pragma unroll
        for (unsigned j = 0; j < 16; ++j) { const unsigned c = xb_ld(&bar[XB_XCNT(j)]); sum += c; cnt += (c > 0u) ? 1u : 0u; mine = (j == x) ? c : mine; }
        if (sum == G) break;
        __builtin_amdgcn_s_sleep(1);
        if ((++sp & 255u) == 0u) { if (xb_ld(&bar[XB_TMO])) break; if (sp > XB_SPIN_CAP) { atomicAdd(&bar[XB_TMO], 1u); break; } }
    }
    nloc = mine > 0u ? mine : 1u; nx = cnt > 0u ? cnt : 1u;
}
DI void xcd_barrier(const Params& pin, lds_t lds) {
    const PP p = launder(pin);
    XcdBarrier b; b.bar = (unsigned*)(p.ws + OFF_BAR); b.st = (volatile LAS unsigned*)(lds + LDS_BYTES - 16);
    asm volatile("s_waitcnt vmcnt(0)" ::: "memory");
    __syncthreads();
    if (threadIdx.x == 0) {
        unsigned* bar = b.bar; b.x = xb_xcc_id();
        __builtin_amdgcn_s_waitcnt(0);
        unsigned nloc = b.st[0], nx = b.st[1];
        if (nloc == 0u) { xcd_barrier_complete(bar, b.x, nloc, nx); b.st[0] = nloc; b.st[1] = nx; }
        const unsigned old = xb_add(&bar[XB_XSUB(b.x)], 1u);
        const unsigned gen = old / nloc;
        if (old + 1u == (gen + 1u) * nloc) {
            __builtin_amdgcn_fence(__ATOMIC_RELEASE, "agent");
            asm volatile("s_waitcnt vmcnt(0)" ::: "memory");
            const unsigned og = xb_add(&bar[XB_TOP], 1u);
            const unsigned tg = og / nx;
            if (og + 1u == (tg + 1u) * nx) xb_add(&bar[XB_TOPGEN], 1u);
            else XB_SPIN(xb_ld(&bar[XB_TOPGEN]) == tg, bar);
            __builtin_amdgcn_fence(__ATOMIC_ACQUIRE, "agent");
            xb_add(&bar[XB_XGEN(b.x)], 1u);
            asm volatile("s_waitcnt vmcnt(0)" ::: "memory");
        } else {
            XB_SPIN(xb_ld(&bar[XB_XGEN(b.x)]) == gen, bar);
            __builtin_amdgcn_fence(__ATOMIC_ACQUIRE, "agent");
            asm volatile("s_waitcnt vmcnt(0)" ::: "memory");
        }
    }
    __syncthreads();
}

#define MFMA16(a, b, c) __builtin_amdgcn_mfma_f32_16x16x32_bf16((a), (b), (c), 0, 0, 0)

namespace pg8 {
constexpr int BM = 256, BK = 64, HALF = 128, HTB = HALF * BK * 2, NXCD = 8, WGM = 8;
DI int lds_byte(int r, int c) { const int st = (r >> 4) * 2 + (c >> 5), rr = r & 15, cc = c & 31, ob = rr * 64 + cc * 2; return st * 1024 + (ob ^ (((ob >> 9) & 1) << 5)); }
DI void stage_rc(int b, int& R, int& C) { const int st = b / 1024, sb = b % 1024, swz = sb ^ (((sb >> 9) & 1) << 5); R = (st >> 1) * 16 + swz / 64; C = (st & 1) * 32 + (swz % 64) / 2; }
DI int perm32(int rho) { const int n = rho >> 4, i = rho & 15; return 8 * (i >> 2) + 4 * n + (i & 3); }
struct Unit { int pm, pn; };
struct Gemm { const bf16_t* A; const bf16_t* Bt; int M, N, K; };
struct StaticOrder {
    int nM, nN, nwg, G, c, skipctx;
    DI void init(int M, int N, int G_, int c_, int skipctx_ = 0) { skipctx = skipctx_; nM = skipctx_ ? 128 : M / BM; nN = N / BM; nwg = nM * nN; G = G_; c = c_; }
    DI bool next(int i, Unit& u) const {
        const long L = (long)i * G + c; if (L >= nwg) return false;
        int wgid = (int)L; { const int q = nwg / NXCD, r = nwg % NXCD, xcd = wgid % NXCD, off = wgid / NXCD; wgid = (xcd < r ? xcd * (q + 1) : r * (q + 1) + (xcd - r) * q) + off; }
        const int nig = WGM * nN, gid = wgid / nig, fm = gid * WGM, gsz = (nM - fm) < WGM ? (nM - fm) : WGM;
        u.pm = fm + ((wgid % nig) % gsz); u.pn = (wgid % nig) / gsz; if (skipctx) u.pm += u.pm / 16 + 1; return true;
    }
};

template <class Epi>
DI void gemm_phase(lds_t lds, const Gemm g, const StaticOrder& S, const Epi& E) {
    const int tid = otid(), wid = __builtin_amdgcn_readfirstlane(tid >> 6), lane = tid & 63, wr = wid >> 2, wc = wid & 3, fr = lane & 15, fq = lane >> 4;
    const int K = g.K, nt = K / BK;
    unsigned voffA[2], voffB[2];
#pragma unroll
    for (int i = 0; i < 2; ++i) { int R, C; stage_rc(tid * 16 + i * 8192, R, C); const int Rb = Epi::PERM ? ((R & ~31) + perm32(R & 31)) : R;
        voffA[i] = (unsigned)(R * K + C) * 2u; voffB[i] = (unsigned)(Rb * K + C) * 2u; }
    const size_t kstep = (size_t)(BK * 2);
    const size_t hstep = (size_t)HALF * K * 2;
    const size_t tstep = 2 * hstep;
    const unsigned ldsw = (unsigned)wid * 1024u;
    const int aoff = lds_byte(wr * 64 + fr, fq * 8), boff = lds_byte(wc * 32 + fr, fq * 8);
#define PG8_SA(b, h) (((b) * 2 + (h)) * HTB)
#define PG8_SB(b, h) ((4 + (b) * 2 + (h)) * HTB)
#define PG8_STAGE(bufoff, gbase, voff) do { _Pragma("unroll") for (int _i = 0; _i < 2; ++_i) \
        __builtin_amdgcn_global_load_lds((const unsigned*)((const char*)(gbase) + (voff)[_i]), (LAS unsigned*)(lds + (bufoff) + ldsw + _i * 8192), 16, 0, 0); } while (0)
#define PG8_LDA(dst, b, h) do { _Pragma("unroll") for (int m = 0; m < 4; ++m) _Pragma("unroll") for (int k = 0; k < 2; ++k) dst[m][k] = *(const LAS bf16x8*)(lds + PG8_SA(b, h) + aoff + m * 2048 + k * 1024); } while (0)
#define PG8_LDB(dst, b, h) do { _Pragma("unroll") for (int n = 0; n < 2; ++n) _Pragma("unroll") for (int k = 0; k < 2; ++k) dst[n][k] = *(const LAS bf16x8*)(lds + PG8_SB(b, h) + boff + n * 2048 + k * 1024); } while (0)
#define PG8_MMA(ai, bj, At, Bt) do { __builtin_amdgcn_s_setprio(1); _Pragma("unroll") for (int m = 0; m < 4; ++m) _Pragma("unroll") for (int n = 0; n < 2; ++n) _Pragma("unroll") for (int k = 0; k < 2; ++k) \
        acc[ai][bj][m][n] = __builtin_amdgcn_mfma_f32_16x16x32_bf16(Bt[n][k], At[m][k], acc[ai][bj][m][n], 0, 0, 0); __builtin_amdgcn_s_setprio(0); } while (0)
#define PG8_WAIT_V(n) asm volatile("s_waitcnt vmcnt(" #n ")" ::: "memory")
#define PG8_WAIT_L(n) asm volatile("s_waitcnt lgkmcnt(" #n ")" ::: "memory")
#define PG8_BAR __builtin_amdgcn_s_barrier()
#define PG8_SCHED __builtin_amdgcn_sched_barrier(0)
    Unit cur, nxt; int ui = 0;
    if (!S.next(0, cur)) return;
    f32x4 acc[2][2][4][2];
#pragma unroll
    for (int a = 0; a < 2; ++a)
#pragma unroll
        for (int b = 0; b < 2; ++b)
#pragma unroll
            for (int m = 0; m < 4; ++m)
#pragma unroll
                for (int n = 0; n < 2; ++n) acc[a][b][m][n] = (f32x4){0.f, 0.f, 0.f, 0.f};
    bf16x8 At[4][2], B0[2][2], B1[2][2];
    const char* cA = (const char*)g.A + (size_t)cur.pm * tstep; const char* cB = (const char*)g.Bt + (size_t)cur.pn * tstep;
    PG8_STAGE(PG8_SB(0, 0), cB, voffB); PG8_STAGE(PG8_SA(0, 0), cA, voffA); PG8_STAGE(PG8_SB(0, 1), cB + hstep, voffB); PG8_STAGE(PG8_SA(0, 1), cA + hstep, voffA);
    if (wr == 1) PG8_BAR;
    PG8_WAIT_V(4); PG8_BAR;
    PG8_STAGE(PG8_SB(1, 0), cB + kstep, voffB); PG8_STAGE(PG8_SA(1, 0), cA + kstep, voffA); PG8_STAGE(PG8_SB(1, 1), cB + hstep + kstep, voffB);
    PG8_WAIT_V(6); PG8_BAR;
    for (;;) {
        const bool has_next = S.next(ui + 1, nxt);
        const char* nA = has_next ? (const char*)g.A + (size_t)nxt.pm * tstep : cA; const char* nB = has_next ? (const char*)g.Bt + (size_t)nxt.pn * tstep : cB;
        for (int t = 0; t < nt; t += 2) {
            const bool last = (t == nt - 2);
            const char* a1 = cA + (size_t)(t + 1) * kstep;
            const char* a2 = last ? nA : cA + (size_t)(t + 2) * kstep; const char* b2 = last ? nB : cB + (size_t)(t + 2) * kstep;
            const char* a3 = a2 + kstep; const char* b3 = b2 + kstep;
            PG8_LDB(B0, 0, 0); PG8_SCHED; PG8_LDA(At, 0, 0); PG8_STAGE(PG8_SA(1, 1), a1 + hstep, voffA);
            PG8_WAIT_L(8); PG8_BAR; PG8_WAIT_L(0); PG8_MMA(0, 0, At, B0); PG8_BAR; PG8_SCHED;
            PG8_LDB(B1, 0, 1); PG8_STAGE(PG8_SB(0, 0), b2, voffB);
            PG8_BAR; PG8_WAIT_L(0); PG8_MMA(0, 1, At, B1); PG8_BAR;
            PG8_LDA(At, 0, 1); PG8_STAGE(PG8_SA(0, 0), a2, voffA);
            PG8_BAR; PG8_WAIT_L(0); PG8_MMA(1, 0, At, B0); PG8_BAR; PG8_SCHED;
            PG8_STAGE(PG8_SB(0, 1), b2 + hstep, voffB);
            PG8_WAIT_V(6); PG8_BAR; PG8_MMA(1, 1, At, B1); PG8_BAR;
            PG8_LDB(B0, 1, 0); PG8_SCHED; PG8_LDA(At, 1, 0); PG8_STAGE(PG8_SA(0, 1), a2 + hstep, voffA);
            PG8_WAIT_L(8); PG8_BAR; PG8_WAIT_L(0); PG8_MMA(0, 0, At, B0); PG8_BAR; PG8_SCHED;
            PG8_LDB(B1, 1, 1); PG8_STAGE(PG8_SB(1, 0), b3, voffB);
            PG8_BAR; PG8_WAIT_L(0); PG8_MMA(0, 1, At, B1); PG8_BAR;
            PG8_LDA(At, 1, 1); PG8_STAGE(PG8_SA(1, 0), a3, voffA);
            PG8_BAR; PG8_WAIT_L(0); PG8_MMA(1, 0, At, B0); PG8_BAR; PG8_SCHED;
            PG8_STAGE(PG8_SB(1, 1), b3 + hstep, voffB);
            PG8_WAIT_V(6); PG8_BAR; PG8_MMA(1, 1, At, B1); PG8_BAR;
        }
        E(acc, cur, wr, wc, fr, fq);
        if (!has_next) break;
#pragma unroll
        for (int a = 0; a < 2; ++a)
#pragma unroll
            for (int b = 0; b < 2; ++b)
#pragma unroll
                for (int m = 0; m < 4; ++m)
#pragma unroll
                    for (int n = 0; n < 2; ++n) acc[a][b][m][n] = (f32x4){0.f, 0.f, 0.f, 0.f};
        cur = nxt; cA = nA; cB = nB; ++ui;
    }
    PG8_WAIT_V(0);
    if (wr == 0) PG8_BAR;
    PG8_BAR;
#undef PG8_SA
#undef PG8_SB
#undef PG8_STAGE
#undef PG8_LDA
#undef PG8_LDB
#undef PG8_MMA
#undef PG8_WAIT_V
#undef PG8_WAIT_L
#undef PG8_BAR
#undef PG8_SCHED
}

struct EpiBf16 {
    static constexpr bool PERM = true;
    bf16_t* O; int ldc;
    DI void operator()(const f32x4 (&acc)[2][2][4][2], const Unit& u, int wr, int wc, int fr, int fq) const {
        const int row0 = u.pm * BM + wr * 64 + fr, col0 = u.pn * BM + wc * 32 + 8 * fq;
#pragma unroll
        for (int ai = 0; ai < 2; ++ai)
#pragma unroll
            for (int m = 0; m < 4; ++m) { bf16_t* rowp = O + (size_t)(row0 + ai * HALF + m * 16) * ldc + col0;
#pragma unroll
                for (int bj = 0; bj < 2; ++bj) { const f32x4 v0 = acc[ai][bj][m][0], v1 = acc[ai][bj][m][1];
                    u32x4 w; w.x = pack2(v0[0], v0[1]); w.y = pack2(v0[2], v0[3]); w.z = pack2(v1[0], v1[1]); w.w = pack2(v1[2], v1[3]);
                    *(u32x4*)(rowp + bj * HALF) = w; } }
    }
};
struct EpiNull { static constexpr bool PERM = false; float* sink;
    DI void operator()(const f32x4 (&acc)[2][2][4][2], const Unit& u, int wr, int wc, int fr, int fq) const { if (acc[0][0][0][0][0] == 12345.678f) sink[0] = 1.f; } };
struct EpiRes {
    static constexpr bool PERM = false;
    float* out; float* hctx; const float* ada_l; int last; const float* xin; const float* cin;
    DI void operator()(const f32x4 (&acc)[2][2][4][2], const Unit& u, int wr, int wc, int fr, int fq) const {
        const int b = u.pm / 17, tt = u.pm % 17;
        float* base; const float* src; const float* g;
        if (tt == 0) { if (last) return; base = hctx + (size_t)b * 256 * 1024; src = cin ? cin + (size_t)b * 256 * 1024 : base; g = ada_l + 8 * 3072 + 2048; }
        else { const size_t o_ = ((size_t)b * 4096 + (size_t)(tt - 1) * 256) * 1024; base = out + o_; src = xin ? xin + o_ : base; g = ada_l + b * 3072 + 2048; }
        const int col0 = u.pn * BM + wc * 32 + 4 * fq;
        f32x4 gv[2][2];
#pragma unroll
        for (int bj = 0; bj < 2; ++bj)
#pragma unroll
            for (int n = 0; n < 2; ++n) gv[bj][n] = *(const f32x4*)(g + col0 + bj * HALF + n * 16);
#pragma unroll
        for (int ai = 0; ai < 2; ++ai)
#pragma unroll
            for (int m = 0; m < 4; ++m) { const size_t ro_ = (size_t)(wr * 64 + fr + ai * HALF + m * 16) * 1024 + col0;
#pragma unroll
                for (int bj = 0; bj < 2; ++bj)
#pragma unroll
                    for (int n = 0; n < 2; ++n) { const f32x4 hv = *(const f32x4*)(src + ro_ + bj * HALF + n * 16); *(f32x4*)(base + ro_ + bj * HALF + n * 16) = hv + gv[bj][n] * acc[ai][bj][m][n]; } }
    }
};
struct EpiGate {
    static constexpr bool PERM = true;
    bf16_t* O; const bf16_t* OCB; const f32x2* stats; const float* hw;
    DI void operator()(const f32x4 (&acc)[2][2][4][2], const Unit& u, int wr, int wc, int fr, int fq) const {
        const int row0 = u.pm * BM + wr * 64 + fr, col0 = u.pn * BM + wc * 32 + 8 * fq;
        const int b = u.pm / 17, tt = u.pm % 17;
        f32x4 hwv[2][2];
#pragma unroll
        for (int bj = 0; bj < 2; ++bj) { hwv[bj][0] = *(const f32x4*)(hw + col0 + bj * HALF); hwv[bj][1] = *(const f32x4*)(hw + col0 + bj * HALF + 4); }
#pragma unroll
        for (int ai = 0; ai < 2; ++ai) {
            u32x4 ov[4][2]; f32x2 st[4][2];
#pragma unroll
            for (int m = 0; m < 4; ++m)
#pragma unroll
                for (int bj = 0; bj < 2; ++bj) { const int row = row0 + ai * HALF + m * 16, col = col0 + bj * HALF;
                    ov[m][bj] = *(const u32x4*)(O + (size_t)row * 2048 + col); st[m][bj] = stats[(size_t)row * 4 + (col >> 9)]; }
#pragma unroll
            for (int m = 0; m < 4; ++m)
#pragma unroll
                for (int bj = 0; bj < 2; ++bj) { const int row = row0 + ai * HALF + m * 16, col = col0 + bj * HALF;
                    const u32x4 v = ov[m][bj];
                    float o[8] = {lo_f(v.x), hi_f(v.x), lo_f(v.y), hi_f(v.y), lo_f(v.z), hi_f(v.z), lo_f(v.w), hi_f(v.w)};
                    if (tt == 0) { const u32x4 cv = *(const u32x4*)(OCB + (size_t)(b * 256 + (row - u.pm * BM)) * 2048 + col);
                        o[0] += lo_f(cv.x); o[1] += hi_f(cv.x); o[2] += lo_f(cv.y); o[3] += hi_f(cv.y); o[4] += lo_f(cv.z); o[5] += hi_f(cv.z); o[6] += lo_f(cv.w); o[7] += hi_f(cv.w); }
                    const float mean = st[m][bj].x, rstd = st[m][bj].y;
                    const f32x4 z0 = acc[ai][bj][m][0], z1 = acc[ai][bj][m][1];
                    float y[8];
#pragma unroll
                    for (int e = 0; e < 4; ++e) { y[e] = (o[e] - mean) * rstd * hwv[bj][0][e] * siluf(z0[e]); y[4 + e] = (o[4 + e] - mean) * rstd * hwv[bj][1][e] * siluf(z1[e]); }
                    u32x4 w; w.x = pack2(y[0], y[1]); w.y = pack2(y[2], y[3]); w.z = pack2(y[4], y[5]); w.w = pack2(y[6], y[7]);
                    *(u32x4*)(O + (size_t)row * 2048 + col) = w; }
        }
    }
};
}

DI void phase0(const Params& p, lds_t lds) {
    const int tid = otid(), bid = obid(), G = gridDim.x;
    if (tid == 0) {
#pragma unroll
        for (int i = 0; i < 38; ++i) ((const float**)(p.ws + OFF_TAB))[i] = p.in[i]; }
    LAS float* sc = (LAS float*)lds;
    LAS float* red = sc + 9 * 1024;
    float* ada = (float*)(p.ws + OFF_ADA);
    bool loaded = false;
    for (int it = bid; it < 192; it += G) {
        if (!loaded) { for (int i = tid; i < 9 * 1024; i += 512) { const float v = i < 8192 ? p.in[1][i] : p.in[3][i - 8192]; sc[i] = siluf(v); } __syncthreads(); loaded = true; }
        const int l = it / 48, cb = it % 48, cl = tid & 63, kp = tid >> 6, col = cb * 64 + cl;
        const float* aw = l == 0 ? p.in[5] : (l == 1 ? p.in[14] : (l == 2 ? p.in[22] : p.in[29])); const float* ab = l == 0 ? p.in[6] : (l == 1 ? p.in[15] : (l == 2 ? p.in[23] : p.in[30]));
        float acc[9];
#pragma unroll
        for (int i = 0; i < 9; ++i) acc[i] = 0.f;
        for (int k = kp * 128; k < kp * 128 + 128; ++k) { const float w = aw[(size_t)k * 3072 + col];
#pragma unroll
            for (int i = 0; i < 9; ++i) acc[i] += sc[i * 1024 + k] * w; }
#pragma unroll
        for (int i = 0; i < 9; ++i) red[(kp * 9 + i) * 64 + cl] = acc[i];
        __syncthreads();
        for (int o = tid; o < 9 * 64; o += 512) { const int i = o >> 6, c = o & 63; float s = 0.f; for (int q = 0; q < 8; ++q) s += red[(q * 9 + i) * 64 + c];
            ada[(size_t)(l * 9 + i) * 3072 + cb * 64 + c] = s + ab[cb * 64 + c]; }
        __syncthreads();
    }
}

DI void transpose_tile(const float* src, int ldsrc, int r0, int c0, bf16_t* dst, int lddst, lds_t lds) {
    LAS float* t = (LAS float*)lds;
    const int tid = otid(), rr = tid >> 3, cs = (tid & 7) * 8;
    const f32x4 a = *(const f32x4*)(src + (size_t)(r0 + rr) * ldsrc + c0 + cs), b = *(const f32x4*)(src + (size_t)(r0 + rr) * ldsrc + c0 + cs + 4);
#pragma unroll
    for (int e = 0; e < 4; ++e) { t[rr * 65 + cs + e] = a[e]; t[rr * 65 + cs + 4 + e] = b[e]; }
    __syncthreads();
    const int c = tid >> 3, rs = (tid & 7) * 8;
    u32x4 w; w.x = pack2(t[(rs + 0) * 65 + c], t[(rs + 1) * 65 + c]); w.y = pack2(t[(rs + 2) * 65 + c], t[(rs + 3) * 65 + c]);
    w.z = pack2(t[(rs + 4) * 65 + c], t[(rs + 5) * 65 + c]); w.w = pack2(t[(rs + 6) * 65 + c], t[(rs + 7) * 65 + c]);
    *(u32x4*)(dst + (size_t)(c0 + c) * lddst + r0 + rs) = w;
    __syncthreads();
}

template <int NG, int STATS>
DI void p1_rows(const PP& pin, lds_t lds, int l, bf16_t* U, const float* inw, int ldin, int goff, const float* gate_b) {
    const PP p = launder(pin);
    const int tid = otid(), wid = tid >> 6, lane = tid & 63;
    LAS float* wT = (LAS float*)lds;
    if (NG > 0) {
        for (int idx = tid; idx < 1024 * NG / 4; idx += 512) { const int k = idx / (NG / 4), n4 = (idx % (NG / 4)) * 4;
            const f32x4 w = *(const f32x4*)(inw + (size_t)k * ldin + goff + n4);
            wT[(n4 + 0) * 1024 + k] = w[0]; wT[(n4 + 1) * 1024 + k] = w[1]; wT[(n4 + 2) * 1024 + k] = w[2]; wT[(n4 + 3) * 1024 + k] = w[3]; }
        __syncthreads();
    }
    const float* nw = tin(p, lbase(l)); const float* ada = (const float*)(p.ws + OFF_ADA) + (size_t)l * 9 * 3072;
    float* gates = (float*)(p.ws + OFF_GATES);
    f32x4 nw4[4];
#pragma unroll
    for (int i = 0; i < 4; ++i) nw4[i] = *(const f32x4*)(nw + lane * 4 + 256 * i);
    auto proc = [&](int row, f32x4 (&x)[4]) {
        const int b = row / LTOK, t = row - b * LTOK; const float* ad = ada + (t < 256 ? 8 : b) * 3072;
        float ss = 0.f;
#pragma unroll
        for (int i = 0; i < 4; ++i) ss += x[i][0] * x[i][0] + x[i][1] * x[i][1] + x[i][2] * x[i][2] + x[i][3] * x[i][3];
        ss = wsum(ss, lane); const float rstd = rsqrtf(ss * (1.f / 1024.f) + 1e-6f);
#pragma unroll
        for (int i = 0; i < 4; ++i) { const f32x4 sh = *(const f32x4*)(ad + lane * 4 + 256 * i), scl = *(const f32x4*)(ad + 1024 + lane * 4 + 256 * i);
            x[i] = x[i] * rstd * nw4[i] * (scl + 1.f) + sh;
            u32x2 w; w.x = pack2(x[i][0], x[i][1]); w.y = pack2(x[i][2], x[i][3]);
            *(u32x2*)(U + (size_t)row * 1024 + lane * 4 + 256 * i) = w; }
        if (STATS) {
            const bf16_t* Og = (const bf16_t*)(p.ws + OFF_RO); const bf16_t* OCB = (const bf16_t*)(p.ws + OFF_OCB); f32x2* stg = (f32x2*)(p.ws + OFF_STATS);
            u32x4 ov[4];
#pragma unroll
            for (int hh = 0; hh < 4; ++hh) ov[hh] = *(const u32x4*)(Og + (size_t)row * 2048 + hh * 512 + lane * 8);
            f32x2 mine = {0.f, 1.f};
#pragma unroll
            for (int hh = 0; hh < 4; ++hh) {
                const int col = hh * 512 + lane * 8;
                float o[8] = {lo_f(ov[hh].x), hi_f(ov[hh].x), lo_f(ov[hh].y), hi_f(ov[hh].y), lo_f(ov[hh].z), hi_f(ov[hh].z), lo_f(ov[hh].w), hi_f(ov[hh].w)};
                if (t < 256) { const u32x4 cv = *(const u32x4*)(OCB + (size_t)(b * 256 + t) * 2048 + col);
                    o[0] += lo_f(cv.x); o[1] += hi_f(cv.x); o[2] += lo_f(cv.y); o[3] += hi_f(cv.y); o[4] += lo_f(cv.z); o[5] += hi_f(cv.z); o[6] += lo_f(cv.w); o[7] += hi_f(cv.w); }
                float mean = 0.f;
                if (STATS == 1) { float sm = 0.f;
#pragma unroll
                    for (int e = 0; e < 8; ++e) sm += o[e];
                    mean = wsum(sm, lane) * (1.f / 512.f); }
                float qq = 0.f;
#pragma unroll
                for (int e = 0; e < 8; ++e) { const float dlt = o[e] - mean; qq += dlt * dlt; }
                const float rs_ = rsqrtf(wsum(qq, lane) * (1.f / 512.f) + 1e-6f);
                if (lane == hh) mine = (f32x2){mean, rs_};
            }
            if (lane < 4) stg[(size_t)row * 4 + lane] = mine;
        }
        if (NG > 0) {
            float v[NG > 0 ? NG : 1];
#pragma unroll
            for (int n = 0; n < NG; ++n) { float sacc = 0.f;
#pragma unroll
                for (int i = 0; i < 4; ++i) { const f32x4 w = *(const LAS f32x4*)(wT + n * 1024 + lane * 4 + 256 * i); sacc += x[i][0] * w[0] + x[i][1] * w[1] + x[i][2] * w[2] + x[i][3] * w[3]; }
                v[n] = sacc; }
#pragma unroll
            for (int k = 0; k < 6; ++k) { const int m = 32 >> k; const int hf = NG >> (k + 1);
                if (hf >= 1) { const bool up = (lane & m) != 0;
#pragma unroll
                    for (int i = 0; i < hf; ++i) { const float keep = up ? v[hf + i] : v[i], send = up ? v[i] : v[hf + i]; v[i] = keep + shx(send, m, lane); } }
                else v[0] += shx(v[0], m, lane);
            }
            const int sh_ = NG == 32 ? 1 : 2, n = lane >> sh_;
            if ((lane & ((1 << sh_) - 1)) == 0) gates[(size_t)row * 32 + n] = v[0] + (gate_b ? gate_b[n] : 0.f);
        }
    };
    const int stride = gridDim.x * 8;
    for (int rowa = blockIdx.x * 8 + wid; rowa < MTOK; rowa += 2 * stride) {
        const int rowb = rowa + stride; const bool hb = rowb < MTOK;
        const float* hpa = hrow(p, rowa, l); const float* hpb = hrow(p, hb ? rowb : rowa, l);
        f32x4 xa[4], xb[4];
#pragma unroll
        for (int i = 0; i < 4; ++i) { xa[i] = *(const f32x4*)(hpa + lane * 4 + 256 * i); xb[i] = *(const f32x4*)(hpb + lane * 4 + 256 * i); }
        proc(rowa, xa);
        if (hb) proc(rowb, xb);
    }
}

DI void weights_prep(const Params& pin, lds_t lds, int l, int first) {
    const PP p = launder(pin);
    const int kind = lkind(l), lb = lbase(l);
    const float* inw = tin(p, lb + 3);
    const int ldin = kind == 0 ? 6160 : (kind == 1 ? 5152 : 6144), nmain = kind == 1 ? 5120 : 6144;
    bf16_t* WT = (bf16_t*)(p.ws + off_wt(l)); bf16_t* WO = (bf16_t*)(p.ws + off_wo(l));
    const float* ow = tin(p, lb + (kind == 0 ? 8 : (kind == 1 ? 7 : 6)));
    const int nt_in = 16 * (nmain / 64), nt_all = nt_in + 32 * 16;
    const int nw = (int)gridDim.x - first;
    if ((int)blockIdx.x < first || nw <= 0) return;
    for (int it = (int)blockIdx.x - first; it < nt_all; it += nw) {
        if (it < nt_in) { const int rt = it % 16, ct = it / 16; transpose_tile(inw, ldin, rt * 64, ct * 64, WT, 1024, lds); }
        else { const int j = it - nt_in, rt = j % 32, ct = j / 32; transpose_tile(ow, 1024, rt * 64, ct * 64, WO, 2048, lds); }
    }
}

DI void phase_p1(const Params& pin, lds_t lds, int l, bool full) {
    const PP p = launder(pin);
    const int kind = lkind(l), lb = lbase(l);
    const float* inw = tin(p, lb + 3);
    const int ldin = kind == 0 ? 6160 : (kind == 1 ? 5152 : 6144), nmain = kind == 1 ? 5120 : 6144;
    if (full) {
        if (l == 0) weights_prep(pin, lds, 0, 0);
        bf16_t* U = (bf16_t*)(p.ws + OFF_RQ);
        if (kind == 0) p1_rows<16, 0>(p, lds, l, U, inw, ldin, 6144, tin(p, lb + 6));
        else if (kind == 1) p1_rows<32, 0>(p, lds, l, U, inw, ldin, 5120, nullptr);
        else p1_rows<0, 0>(p, lds, l, U, inw, ldin, 0, nullptr);
    } else {
#ifdef FUSE_GATE
        if (kind == 1) p1_rows<0, 2>(p, lds, l, (bf16_t*)(p.ws + OFF_RQ), inw, ldin, 0, nullptr);
        else p1_rows<0, 1>(p, lds, l, (bf16_t*)(p.ws + OFF_RQ), inw, ldin, 0, nullptr);
#else
        p1_rows<0, 0>(p, lds, l, (bf16_t*)(p.ws + OFF_RQ), inw, ldin, 0, nullptr);
#endif
    }
}

DI int chunk_of(int dir, int s) { return dir == 0 ? s : (s < 4 ? 3 - s : 71 - s); }

DI void mlstm_chain(const Params& pin, lds_t lds, int b, int h) {
    const PP p = launder(pin);
    const int tid = otid(), wid = tid >> 6, lane = tid & 63;
    LAS float* btok = (LAS float*)lds;
    LAS float* ctok = btok + 2 * LTOK;
    LAS float* ptok = ctok + 2 * LTOK;
    LAS float* Bc = ptok + 2 * LTOK;
    LAS float* PMc = Bc + 136;
    LAS float* Mst = PMc + 136;
    const float* gates = (const float*)(p.ws + OFF_GATES);
    for (int q = wid; q < 136; q += 8) {
        const int dir = q / 68, c = q % 68;
        const int tk = c * 64 + (dir ? 63 - lane : lane);
        const float* gr = gates + (size_t)(b * LTOK + tk) * 32 + dir * 8 + h;
        const float gi = gr[0], lf = logsig(gr[4]);
        float bc = lf;
#pragma unroll
        for (int o = 1; o < 64; o <<= 1) { const float t = shup(bc, o, lane); if (lane >= o) bc += t; }
        const float cc = gi - bc; float pm = cc;
#pragma unroll
        for (int o = 1; o < 64; o <<= 1) { const float t = shup(pm, o, lane); if (lane >= o) pm = fmaxf(pm, t); }
        btok[dir * LTOK + tk] = bc; ctok[dir * LTOK + tk] = cc; ptok[dir * LTOK + tk] = pm;
        if (lane == 63) { Bc[q] = bc; PMc[q] = pm; }
    }
    __syncthreads();
    if (tid < 2) { float m = 0.f; for (int s = 0; s < 68; ++s) { const int c = chunk_of(tid, s); Mst[tid * 68 + c] = m; m = Bc[tid * 68 + c] + fmaxf(m, PMc[tid * 68 + c]); } }
    __syncthreads();
    float* SA = (float*)(p.ws + OFF_SA); float* SC = (float*)(p.ws + OFF_SC); float* SR = (float*)(p.ws + OFF_SR);
    float* SF = (float*)(p.ws + OFF_SF); float* SK = (float*)(p.ws + OFF_SK); float* DECS = (float*)(p.ws + OFF_DECS);
    for (int idx = tid; idx < 2 * LTOK; idx += 512) {
        const int dir = idx / LTOK, tk = idx - dir * LTOK, c = tk >> 6;
        const float mst = Mst[dir * 68 + c], pm = ptok[idx], cc = ctok[idx], bb = btok[idx];
        const float mx = fmaxf(mst, pm), mxe = fmaxf(mst, PMc[dir * 68 + c]);
        const size_t si = (size_t)((dir * 8 + b) * 4 + h) * LTOK + tk;
        SA[si] = -mx; SC[si] = cc; SR[si] = __expf(mst - mx); SF[si] = __expf(-mx - bb); SK[si] = __expf(cc - mxe);
    }
    if (tid < 136) { const int dir = tid / 68, c = tid % 68; const float mst = Mst[tid]; DECS[((dir * 8 + b) * 4 + h) * 68 + c] = __expf(mst - fmaxf(mst, PMc[tid])); }
    __syncthreads();
}

template <int DK, int kind>
DI void phase_p3(const Params& pin, lds_t lds, int l) {
    const PP p = launder(pin);
    constexpr int QSTR = DK * 2 + 16;
    const int tid = otid(), wid = tid >> 6, lane = tid & 63, fr = lane & 15, fq = lane >> 4;
    lds_t Qt = lds, Kt = lds + 64 * QSTR, Kh = lds + 128 * QSTR;
    LAS float* misc = (LAS float*)(lds + 192 * QSTR);
    LAS float* fA = misc; LAS float* fC = misc + 128; LAS float* rsl = misc + 256;
    LAS float* code = misc + 512;
    LAS float* Bc = misc + 512 + 1024;
    LAS float* tot = Bc + 64 * 128;
    const bf16_t* QK = (const bf16_t*)(p.ws + OFF_RO);
    bf16_t* Qs = (bf16_t*)(p.ws + OFF_RQ); bf16_t* KTg = (bf16_t*)(p.ws + OFF_RK); bf16_t* Sg = (bf16_t*)(p.ws + OFF_RS);
    float* SA = (float*)(p.ws + OFF_SA); float* SC = (float*)(p.ws + OFF_SC); float* SR = (float*)(p.ws + OFF_SR);
    float* SK = (float*)(p.ws + OFF_SK); float* RSUM = (float*)(p.ws + OFF_RSUM); float* DECS = (float*)(p.ws + OFF_DECS); float* DEC = (float*)(p.ws + OFF_DEC);
    const int lb = lbase(l);
    for (int it = blockIdx.x; it < 8 * 68 * 4; it += gridDim.x) {
        const int h = it & 3, c = (it >> 2) % 68, b = it / (4 * 68);
        const int row0 = b * LTOK + c * 64;
        const int npass = (kind == 1) ? 2 : 1;
        for (int pass = 0; pass < npass; ++pass) {
            if (kind == 0) {
                const float* cw = tin(p, lb + 4); const float* cbias = tin(p, lb + 5);
                if (tid < 128) { const int dir = tid >> 6, jj = tid & 63; const size_t si = (size_t)((dir * 8 + b) * 4 + h) * LTOK + c * 64 + jj; fA[tid] = SA[si]; fC[tid] = SC[si]; }
                const int pc = tid & 63, x0 = (tid >> 6) * 8, which = pc >> 5, cc0 = (pc & 31) * 8, col = which * 1024 + h * 256 + cc0;
                float acc[8][8];
                { const f32x4 b0 = *(const f32x4*)(cbias + col), b1 = *(const f32x4*)(cbias + col + 4);
#pragma unroll
                  for (int xo = 0; xo < 8; ++xo)
#pragma unroll
                      for (int e = 0; e < 4; ++e) { acc[xo][e] = b0[e]; acc[xo][4 + e] = b1[e]; } }
#pragma unroll
                for (int dy = 0; dy < 3; ++dy) {
                    const int yy = c - 4 + dy - 1;
                    const bool rowok = c >= 4 ? (yy >= 0 && yy < 64) : (dy == 1);
                    if (rowok) {
                        float w[3][8];
#pragma unroll
                        for (int dx = 0; dx < 3; ++dx) { const f32x4 w0 = *(const f32x4*)(cw + (dy * 3 + dx) * 2048 + col), w1 = *(const f32x4*)(cw + (dy * 3 + dx) * 2048 + col + 4);
#pragma unroll
                            for (int e = 0; e < 4; ++e) { w[dx][e] = w0[e]; w[dx][4 + e] = w1[e]; } }
                        const int rbase = c >= 4 ? (b * LTOK + 256 + yy * 64) : (b * LTOK + c * 64);
                        const int lo = c >= 4 ? 0 : -(c * 64), hi = c >= 4 ? 64 : 256 - c * 64;
#pragma unroll
                        for (int xi = -1; xi <= 8; ++xi) {
                            const int x = x0 + xi;
                            u32x4 v = {0u, 0u, 0u, 0u};
                            if (x >= lo && x < hi) v = *(const u32x4*)(QK + (size_t)(rbase + x) * 2048 + col);
                            const float f[8] = {lo_f(v.x), hi_f(v.x), lo_f(v.y), hi_f(v.y), lo_f(v.z), hi_f(v.z), lo_f(v.w), hi_f(v.w)};
#pragma unroll
                            for (int dx = 0; dx < 3; ++dx) { const int xo = xi + 1 - dx;
                                if (xo >= 0 && xo < 8) {
#pragma unroll
                                    for (int e = 0; e < 8; ++e) acc[xo][e] += f[e] * w[dx][e]; } }
                        }
                    }
                }
                const float sc = which ? 0.0625f : 1.f;
#pragma unroll
                for (int xo = 0; xo < 8; ++xo) {
                    float y[8];
#pragma unroll
                    for (int e = 0; e < 8; ++e) y[e] = siluf(acc[xo][e]) * sc;
                    u32x4 w; w.x = pack2(y[0], y[1]); w.y = pack2(y[2], y[3]); w.z = pack2(y[4], y[5]); w.w = pack2(y[6], y[7]);
                    *(LAS u32x4*)((which ? Kt : Qt) + (x0 + xo) * QSTR + cc0 * 2) = w;
                }
            } else if (kind == 2) {
                const float* dl = tin(p, lb + 4);
                if (tid < 128) { const int dir = tid >> 6, jj = tid & 63; const float lg = logsig(dl[dir * 4 + h]); const float fj = (float)jj;
                    fA[tid] = dir == 0 ? fj * lg : -fj * lg; fC[tid] = dir == 0 ? -fj * lg : fj * lg;
                    const size_t si = (size_t)((dir * 8 + b) * 4 + h) * LTOK + c * 64 + jj;
                    SR[si] = dir == 0 ? __expf((fj + 1.f) * lg) : __expf((64.f - fj) * lg);
                    SK[si] = dir == 0 ? __expf((63.f - fj) * lg) : __expf(fj * lg);
                    if (jj == 0) DECS[((dir * 8 + b) * 4 + h) * 68 + c] = __expf(64.f * lg); }
                const int j = tid >> 3, g = tid & 7;
#pragma unroll
                for (int half = 0; half < 2; ++half) {
                    const float pos = half == 0 ? (float)(c - 4) : (float)j;
                    float cs[8], sn[8];
#pragma unroll
                    for (int e = 0; e < 8; ++e) { const int i = g * 8 + e; const float f = exp2f(-(float)i * (13.287712379549449f / 64.f));
                        float rev = pos * f * 0.15915494309189535f; rev -= rintf(rev);
                        cs[e] = c >= 4 ? __builtin_amdgcn_cosf(rev) : 1.f; sn[e] = c >= 4 ? __builtin_amdgcn_sinf(rev) : 0.f; }
#pragma unroll
                    for (int which = 0; which < 2; ++which) {
                        const int col = which * 1024 + h * 256 + half * 128 + g * 8;
                        const u32x4 v1 = *(const u32x4*)(QK + (size_t)(row0 + j) * 2048 + col), v2 = *(const u32x4*)(QK + (size_t)(row0 + j) * 2048 + col + 64);
                        float x1[8] = {lo_f(v1.x), hi_f(v1.x), lo_f(v1.y), hi_f(v1.y), lo_f(v1.z), hi_f(v1.z), lo_f(v1.w), hi_f(v1.w)};
                        float x2[8] = {lo_f(v2.x), hi_f(v2.x), lo_f(v2.y), hi_f(v2.y), lo_f(v2.z), hi_f(v2.z), lo_f(v2.w), hi_f(v2.w)};
                        float o1[8], o2[8]; const float sc = which ? 0.0625f : 1.f;
#pragma unroll
                        for (int e = 0; e < 8; ++e) { o1[e] = (x1[e] * cs[e] - x2[e] * sn[e]) * sc; o2[e] = (x1[e] * sn[e] + x2[e] * cs[e]) * sc; }
                        u32x4 w1, w2; w1.x = pack2(o1[0], o1[1]); w1.y = pack2(o1[2], o1[3]); w1.z = pack2(o1[4], o1[5]); w1.w = pack2(o1[6], o1[7]);
                        w2.x = pack2(o2[0], o2[1]); w2.y = pack2(o2[2], o2[3]); w2.z = pack2(o2[4], o2[5]); w2.w = pack2(o2[6], o2[7]);
                        lds_t dst = (which ? Kt : Qt) + j * QSTR + (half * 128 + g * 8) * 2;
                        *(LAS u32x4*)dst = w1; *(LAS u32x4*)(dst + 128) = w2;
                    }
                }
            } else {
                const int dir = pass;
                const float* gates = (const float*)(p.ws + OFF_GATES);
                const float* w2 = tin(p, lb + 4) + (size_t)dir * 16 * 512; const float* gb = tin(p, lb + 5) + dir * 512;
                for (int idx = tid; idx < 1024; idx += 512) { const int ll = idx >> 4, r = idx & 15; code[idx] = gates[(size_t)(row0 + ll) * 32 + dir * 16 + r]; }
                if (tid < 128) { fA[tid] = 0.f; fC[tid] = 0.f; }
                __syncthreads();
                const int d = tid & 127, g = tid >> 7;
                float wr_[16];
#pragma unroll
                for (int r = 0; r < 16; ++r) wr_[r] = w2[r * 512 + h * 128 + d];
                const float bias = gb[h * 128 + d];
                float run = 0.f;
                for (int q = 0; q < 16; ++q) { const int pp = g * 16 + q, ll = dir ? 63 - pp : pp; float pre = bias;
#pragma unroll
                    for (int r = 0; r < 16; ++r) pre += code[ll * 16 + r] * wr_[r];
                    run += logsig(pre) * (1.f / 16.f); Bc[pp * 128 + d] = run; }
                tot[g * 128 + d] = run;
                __syncthreads();
                float off = 0.f, bend = 0.f;
#pragma unroll
                for (int gg = 0; gg < 4; ++gg) { const float t = tot[gg * 128 + d]; if (gg < g) off += t; bend += t; }
                for (int q = 0; q < 16; ++q) { const int pp = g * 16 + q, ll = dir ? 63 - pp : pp; const float bf = Bc[pp * 128 + d] + off;
                    const float qv = bf2f(QK[(size_t)(row0 + ll) * 1024 + h * 128 + d]), kv = bf2f(QK[(size_t)(row0 + ll) * 1024 + 512 + h * 128 + d]);
                    *(LAS bf16_t*)(Qt + ll * QSTR + d * 2) = f2bf(qv * 0.08838834764831845f * __expf(bf));
                    *(LAS bf16_t*)(Kt + ll * QSTR + d * 2) = f2bf(kv * __expf(-bf));
                    *(LAS bf16_t*)(Kh + ll * QSTR + d * 2) = f2bf(kv * __expf(bend - bf)); }
                if (g == 0) DEC[(size_t)(((dir * 8 + b) * 4 + h) * 68 + c) * 128 + d] = __expf(bend);
            }
            __syncthreads();
            {
                const int rb = wid & 3, cbp = wid >> 2;
                f32x4 a0 = {0.f, 0.f, 0.f, 0.f}, a1 = {0.f, 0.f, 0.f, 0.f};
#pragma unroll
                for (int kk = 0; kk < DK / 32; ++kk) {
                    const bf16x8 A = *(const LAS bf16x8*)(Qt + (16 * rb + fr) * QSTR + kk * 64 + fq * 16);
                    const bf16x8 B0 = *(const LAS bf16x8*)(Kt + (32 * cbp + fr) * QSTR + kk * 64 + fq * 16);
                    const bf16x8 B1 = *(const LAS bf16x8*)(Kt + (32 * cbp + 16 + fr) * QSTR + kk * 64 + fq * 16);
                    a0 = MFMA16(A, B0, a0); a1 = MFMA16(A, B1, a1);
                }
                for (int dd = (kind == 1 ? pass : 0); dd < (kind == 1 ? pass + 1 : 2); ++dd) {
                    bf16_t* St = Sg + (size_t)(((dd * 8 + b) * 4 + h) * 68 + c) * 4096;
                    float rs[4] = {0.f, 0.f, 0.f, 0.f};
#pragma unroll
                    for (int t = 0; t < 2; ++t) { const int ll = 32 * cbp + 16 * t + fr; const float cl = fC[dd * 64 + ll];
#pragma unroll
                        for (int i = 0; i < 4; ++i) { const int j = 16 * rb + 4 * fq + i; const bool ok = dd == 0 ? (ll <= j) : (ll >= j);
                            const float a = t == 0 ? a0[i] : a1[i];
                            const float v = ok ? (kind == 1 ? a : a * __expf(fA[dd * 64 + j] + cl)) : 0.f;
                            const bf16_t hb = f2bf(v); St[j * 64 + ll] = hb; rs[i] += bf2f(hb); } }
                    if (kind == 0) {
#pragma unroll
                        for (int i = 0; i < 4; ++i) { float s = rs[i]; s += shx(s, 1, lane); s += shx(s, 2, lane); s += shx(s, 4, lane); s += shx(s, 8, lane);
                            if (fr == 0) rsl[(dd * 2 + cbp) * 64 + 16 * rb + 4 * fq + i] = s; }
                    }
                }
            }
            if (kind != 1) {
#pragma unroll
                for (int i = 0; i < 4; ++i) { const int pi = tid + 512 * i, j = pi >> 5, d8 = pi & 31;
                    *(u32x4*)(Qs + (size_t)(row0 + j) * 1024 + h * 256 + d8 * 8) = *(const LAS u32x4*)(Qt + j * QSTR + d8 * 16); }
            } else {
#pragma unroll
                for (int i = 0; i < 2; ++i) { const int pi = tid + 512 * i, j = pi >> 4, d8 = pi & 15;
                    *(u32x4*)(Qs + (size_t)pass * MTOK * 512 + (size_t)(row0 + j) * 512 + h * 128 + d8 * 8) = *(const LAS u32x4*)(Qt + j * QSTR + d8 * 16); }
            }
            {
                lds_t Ksrc = kind == 1 ? Kh : Kt;
                bf16_t* KTt = KTg + (size_t)((kind == 1 ? ((pass * 8 + b) * 4 + h) : (b * 4 + h)) * 68 + c) * (DK * 64);
#pragma unroll
                for (int i = 0; i < DK / 64; ++i) { const int pi = tid + 512 * i, d = pi >> 3, l8 = pi & 7;
                    unsigned x[8];
#pragma unroll
                    for (int e = 0; e < 8; ++e) x[e] = *(const LAS bf16_t*)(Ksrc + (l8 * 8 + e) * QSTR + d * 2);
                    u32x4 w; w.x = x[0] | (x[1] << 16); w.y = x[2] | (x[3] << 16); w.z = x[4] | (x[5] << 16); w.w = x[6] | (x[7] << 16);
                    *(u32x4*)(KTt + d * 64 + l8 * 8) = w; }
            }
            __syncthreads();
            if (kind == 0 && tid < 128) { const int dir = tid >> 6, jj = tid & 63;
                RSUM[(size_t)((dir * 8 + b) * 4 + h) * LTOK + c * 64 + jj] = rsl[(dir * 2) * 64 + jj] + rsl[(dir * 2 + 1) * 64 + jj]; }
        }
    }
}

template <int DK>
struct ScanState { f32x4 st[DK / 16]; float nreg; };

template <int DK>
DI void scan_steps(const Params& pin, lds_t lds, int kind, int item, int s_lo, int s_hi, ScanState<DK>& S) {
    const PP p = launder(pin);
    constexpr int QSTR = DK * 2 + 16, NT = DK / 16;
    const int tid = otid(), wid = tid >> 6, lane = tid & 63, fr = lane & 15, fq = lane >> 4;
    const int xcd = item & 7, slot = item >> 3, bh = xcd * 4 + (slot >> 3), sub = slot & 7, dir = sub >> 2, vs = sub & 3, b = bh >> 2, h = bh & 3;
    lds_t Ql = lds, KTl = lds + 64 * QSTR, VTl = KTl + DK * 144, Sl = VTl + 128 * 144;
    LAS float* misc = (LAS float*)(Sl + 64 * 144);
    LAS float* rl = misc; LAS float* rsl = misc + 64; LAS float* fll = misc + 128; LAS float* qnl = misc + 192; LAS float* decl = misc + 256;
    LAS float* nl = misc + 384;
    LAS float* rrl = misc + 896;
    const bf16_t* Qg = (const bf16_t*)(p.ws + OFF_RQ) + (kind == 1 ? (size_t)dir * MTOK * 512 : 0);
    const int ldq = kind == 1 ? 512 : 1024;
    const bf16_t* KTg = (const bf16_t*)(p.ws + OFF_RK); const bf16_t* VT = (const bf16_t*)(p.ws + OFF_R0); const bf16_t* Sg = (const bf16_t*)(p.ws + OFF_RS);
    const float* SR = (const float*)(p.ws + OFF_SR); const float* SF = (const float*)(p.ws + OFF_SF); const float* SK = (const float*)(p.ws + OFF_SK);
    const float* RSUM = (const float*)(p.ws + OFF_RSUM); const float* DECS = (const float*)(p.ws + OFF_DECS); const float* DEC = (const float*)(p.ws + OFF_DEC);
    bf16_t* Og = (bf16_t*)(p.ws + OFF_RO); bf16_t* OCB = (bf16_t*)(p.ws + OFF_OCB);
    const int dbh = (dir * 8 + b) * 4 + h;
    u32x4 pq[DK / 64], pk[DK / 64], pv[2], ps; float pks = 1.f;
    float pr = 1.f, prs = 0.f, pfl = 1.f, pdec = 1.f, pdsc = 1.f;
    const int l8 = tid & 7;
    const unsigned voffO = (unsigned)(fr * 2048 + 16 * wid + 4 * fq) * 2u;
    const unsigned voffF = (unsigned)tid * 4u, voffR = (unsigned)(tid / (DK / 8)) * 4u;
    const unsigned voffQ = (unsigned)((tid / (DK / 8)) * ldq + (tid % (DK / 8)) * 8) * 2u, voffT = (unsigned)tid * 16u, voffV = (unsigned)((tid >> 3) * MTOK + l8 * 8) * 2u;
    const __amdgpu_buffer_rsrc_t rs_ws = __builtin_amdgcn_make_buffer_rsrc((void*)p.ws, (short)0, (int)WS_END, 0x00020000);
    const unsigned qdir_ = (unsigned)OFF_RQ + (kind == 1 ? (unsigned)dir * (unsigned)(MTOK * 512 * 2) : 0u);
#define SCAN_ISSUE(sn) do { \
        const int c_ = chunk_of(dir, (sn)), row0_ = b * LTOK + c_ * 64; const unsigned sidx4_ = (unsigned)(dbh * LTOK + c_ * 64) * 4u; \
        const unsigned qs_ = qdir_ + (unsigned)(row0_ * ldq + h * DK) * 2u; \
        _Pragma("unroll") for (int i = 0; i < DK / 64; ++i) pq[i] = __builtin_amdgcn_raw_buffer_load_b128(rs_ws, voffQ, qs_ + (unsigned)(i * (4096 / DK) * ldq * 2), 0); \
        const unsigned ks_ = (unsigned)OFF_RK + (unsigned)(((kind == 1 ? dbh : (b * 4 + h)) * 68 + c_) * (DK * 64)) * 2u; \
        _Pragma("unroll") for (int i = 0; i < DK / 64; ++i) pk[i] = __builtin_amdgcn_raw_buffer_load_b128(rs_ws, voffT, ks_ + (unsigned)(i * 8192), 0); \
        if (kind != 1 && tid < 64) pks = __builtin_bit_cast(float, __builtin_amdgcn_raw_buffer_load_b32(rs_ws, voffF, (unsigned)OFF_SK + sidx4_, 0)); \
        const unsigned vs_ = (unsigned)OFF_R0 + (unsigned)((h * 512 + vs * 128) * MTOK + row0_) * 2u; \
        _Pragma("unroll") for (int i = 0; i < 2; ++i) pv[i] = __builtin_amdgcn_raw_buffer_load_b128(rs_ws, voffV, vs_ + (unsigned)(i * 64 * MTOK * 2), 0); \
        ps = __builtin_amdgcn_raw_buffer_load_b128(rs_ws, voffT, (unsigned)OFF_RS + (unsigned)((dbh * 68 + c_) * 4096) * 2u, 0); \
        if (kind != 1 && tid < 64) pr = __builtin_bit_cast(float, __builtin_amdgcn_raw_buffer_load_b32(rs_ws, voffF, (unsigned)OFF_SR + sidx4_, 0)); \
        if (kind == 0 && tid < 64) { prs = __builtin_bit_cast(float, __builtin_amdgcn_raw_buffer_load_b32(rs_ws, voffF, (unsigned)OFF_RSUM + sidx4_, 0)); \
                                     pfl = __builtin_bit_cast(float, __builtin_amdgcn_raw_buffer_load_b32(rs_ws, voffF, (unsigned)OFF_SF + sidx4_, 0)); } \
        if (kind == 1 && tid < 128) pdec = __builtin_bit_cast(float, __builtin_amdgcn_raw_buffer_load_b32(rs_ws, voffF, (unsigned)OFF_DEC + (unsigned)((dbh * 68 + c_) * 128) * 4u, 0)); \
        if (kind != 1) pdsc = DECS[dbh * 68 + c_]; \
    } while (0)
    SCAN_ISSUE(s_lo);
    for (int s = s_lo; s < s_hi; ++s) {
        const int c = chunk_of(dir, s), row0 = b * LTOK + c * 64, par = s & 1;
        {
#pragma unroll
            for (int i = 0; i < DK / 64; ++i) { const int pi = tid + 512 * i, j = pi / (DK / 8), d8 = pi % (DK / 8);
                *(LAS u32x4*)(Ql + j * QSTR + d8 * 16) = pq[i]; }
#pragma unroll
            for (int i = 0; i < DK / 64; ++i) { const int pi = tid + 512 * i, d = pi >> 3;
                *(LAS u32x4*)(KTl + d * 144 + l8 * 16) = pk[i]; }
#pragma unroll
            for (int i = 0; i < 2; ++i) { const int pi = tid + 512 * i, vr = pi >> 3; *(LAS u32x4*)(VTl + vr * 144 + l8 * 16) = pv[i]; }
            *(LAS u32x4*)(Sl + (tid >> 3) * 144 + l8 * 16) = ps;
            if (kind == 0 && tid < 64) { rsl[tid] = prs; fll[tid] = pfl; }
            if (kind != 1 && tid < 64) { rl[tid] = pks; rrl[tid] = pr; }
            if (kind == 0 && tid < 64) ((LAS bf16_t*)decl)[tid] = f2bf(pks);
            if (kind == 1 && tid < 128) decl[tid] = pdec;
        }
        const float dsc = pdsc;
        __syncthreads();
        u32x2 oo[4];
        if (s >= 36) {
#pragma unroll
            for (int rb = 0; rb < 4; ++rb) oo[rb] = __builtin_amdgcn_raw_buffer_load_b64(rs_ws, voffO, (unsigned)OFF_RO + (unsigned)((row0 + 16 * rb) * 2048 + h * 512 + vs * 128) * 2u, 0); }
        if (s + 1 < s_hi) SCAN_ISSUE(s + 1);
        if (kind == 0) {
            LAS unsigned char* nlb = (LAS unsigned char*)nl;
            { const int j = tid >> 3, part = tid & 7; float a = 0.f;
#pragma unroll
              for (int q = 0; q < 4; ++q) { const u32x4 v = *(const LAS u32x4*)(Ql + j * QSTR + (part * 32 + q * 8) * 2);
                  const u32x4 nn = *(const LAS u32x4*)(nlb + par * 512 + (part * 32 + q * 8) * 2);
                  a = dot2(v.x, nn.x, a); a = dot2(v.y, nn.y, a); a = dot2(v.z, nn.z, a); a = dot2(v.w, nn.w, a); }
              a += shx(a, 1, lane); a += shx(a, 2, lane); a += shx(a, 4, lane);
              if (part == 0) qnl[j] = a; }
            if (tid < DK) { float sum = 0.f;
#pragma unroll
                for (int q = 0; q < 8; ++q) { const u32x4 v = *(const LAS u32x4*)(KTl + tid * 144 + q * 16);
                    const u32x4 kk = *(const LAS u32x4*)((LAS unsigned char*)decl + q * 16);
                    sum = dot2(v.x, kk.x, sum); sum = dot2(v.y, kk.y, sum); sum = dot2(v.z, kk.z, sum); sum = dot2(v.w, kk.w, sum); }
                S.nreg = dsc * S.nreg + sum; *(LAS bf16_t*)(nlb + (par ^ 1) * 512 + tid * 2) = f2bf(S.nreg); }
            __syncthreads();
        }
        f32x4 ax[4];
#pragma unroll
        for (int rb = 0; rb < 4; ++rb) ax[rb] = (f32x4){0.f, 0.f, 0.f, 0.f};
        u32x4 fa[2][4];
#define SCAN_LOADQ(slot, kk_) do { _Pragma("unroll") for (int rb = 0; rb < 4; ++rb) { \
            const u32x2 q0_ = *(const LAS u32x2*)(Ql + (16 * rb + fr) * QSTR + (32 * (kk_) + 4 * fq) * 2); \
            const u32x2 q1_ = *(const LAS u32x2*)(Ql + (16 * rb + fr) * QSTR + (32 * (kk_) + 16 + 4 * fq) * 2); \
            fa[slot][rb] = (u32x4){q0_.x, q0_.y, q1_.x, q1_.y}; } } while (0)
#define SCAN_LOADS(slot, ks_) do { _Pragma("unroll") for (int rb = 0; rb < 4; ++rb) \
            fa[slot][rb] = *(const LAS u32x4*)(Sl + (16 * rb + fr) * 144 + (ks_) * 64 + fq * 16); } while (0)
#define SCAN_LOADK(slot, tp_) do { _Pragma("unroll") for (int q_ = 0; q_ < 4; ++q_) \
            fa[slot][q_] = *(const LAS u32x4*)(KTl + (16 * (2 * (tp_) + (q_ >> 1)) + fr) * 144 + (q_ & 1) * 64 + fq * 16); } while (0)
        constexpr int NKK = DK / 32;
        SCAN_LOADQ(0, 0);
#pragma unroll
        for (int kk = 0; kk < NKK; ++kk) {
            if (kk + 1 < NKK) SCAN_LOADQ((kk + 1) & 1, kk + 1); else SCAN_LOADS((kk + 1) & 1, 0);
            __builtin_amdgcn_sched_barrier(0);
            u32x4 sw; sw.x = pack2(S.st[2 * kk][0], S.st[2 * kk][1]); sw.y = pack2(S.st[2 * kk][2], S.st[2 * kk][3]);
            sw.z = pack2(S.st[2 * kk + 1][0], S.st[2 * kk + 1][1]); sw.w = pack2(S.st[2 * kk + 1][2], S.st[2 * kk + 1][3]);
            const bf16x8 sf = __builtin_bit_cast(bf16x8, sw);
#pragma unroll
            for (int rb = 0; rb < 4; ++rb) ax[rb] = MFMA16(sf, __builtin_bit_cast(bf16x8, fa[kk & 1][rb]), ax[rb]);
            __builtin_amdgcn_sched_barrier(0);
        }
        bf16x8 bv[2];
#pragma unroll
        for (int ks = 0; ks < 2; ++ks) bv[ks] = *(const LAS bf16x8*)(VTl + (16 * wid + fr) * 144 + ks * 64 + fq * 16);
        SCAN_LOADS((NKK + 1) & 1, 1);
        float rj[4] = {1.f, 1.f, 1.f, 1.f};
        if (kind != 1) {
#pragma unroll
            for (int rb = 0; rb < 4; ++rb) rj[rb] = rrl[16 * rb + fr]; }
        __builtin_amdgcn_sched_barrier(0);
        if (kind != 1) {
#pragma unroll
            for (int rb = 0; rb < 4; ++rb) ax[rb] = ax[rb] * rj[rb]; }
#pragma unroll
        for (int rb = 0; rb < 4; ++rb) ax[rb] = MFMA16(bv[0], __builtin_bit_cast(bf16x8, fa[NKK & 1][rb]), ax[rb]);
        __builtin_amdgcn_sched_barrier(0);
        SCAN_LOADK(NKK & 1, 0);
        __builtin_amdgcn_sched_barrier(0);
#pragma unroll
        for (int rb = 0; rb < 4; ++rb) ax[rb] = MFMA16(bv[1], __builtin_bit_cast(bf16x8, fa[(NKK + 1) & 1][rb]), ax[rb]);
        __builtin_amdgcn_sched_barrier(0);
        const bool to_cb = (dir == 1) && (s < 4);
#pragma unroll
        for (int rb = 0; rb < 4; ++rb) { const int j = 16 * rb + fr;
            f32x4 v = ax[rb];
            { if (kind == 0) { const float den = rsl[j] + rj[rb] * qnl[j]; const float inv = __builtin_amdgcn_rcpf(fmaxf(fabsf(den), fll[j])); v = v * inv; } }
            const unsigned dsto = (to_cb ? (unsigned)OFF_OCB + (unsigned)((b * 256 + c * 64 + 16 * rb) * 2048) * 2u : (unsigned)OFF_RO + (unsigned)((row0 + 16 * rb) * 2048) * 2u) + (unsigned)(h * 512 + vs * 128) * 2u;
            if (s >= 36) { const u32x2 o = oo[rb]; v[0] += lo_f(o.x); v[1] += hi_f(o.x); v[2] += lo_f(o.y); v[3] += hi_f(o.y); }
            u32x2 w; w.x = pack2(v[0], v[1]); w.y = pack2(v[2], v[3]); __builtin_amdgcn_raw_buffer_store_b64(w, rs_ws, voffO, dsto, 0); }
        bf16x8 bvs[2];
#pragma unroll
        for (int ks = 0; ks < 2; ++ks) {
            if (kind != 1) { const f32x4 c0 = *(const LAS f32x4*)(rl + 32 * ks + 8 * fq), c1 = *(const LAS f32x4*)(rl + 32 * ks + 8 * fq + 4);
                const u32x4 v = __builtin_bit_cast(u32x4, bv[ks]); u32x4 w;
                w.x = pack2(lo_f(v.x) * c0[0], hi_f(v.x) * c0[1]); w.y = pack2(lo_f(v.y) * c0[2], hi_f(v.y) * c0[3]);
                w.z = pack2(lo_f(v.z) * c1[0], hi_f(v.z) * c1[1]); w.w = pack2(lo_f(v.w) * c1[2], hi_f(v.w) * c1[3]);
                bvs[ks] = __builtin_bit_cast(bf16x8, w); }
            else bvs[ks] = bv[ks];
        }
        __builtin_amdgcn_sched_barrier(0);
        constexpr int NTP = NT / 2;
#pragma unroll
        for (int tp = 0; tp < NTP; ++tp) {
            const int cur = (NKK + tp) & 1;
            if (tp + 1 < NTP) SCAN_LOADK(cur ^ 1, tp + 1);
            __builtin_amdgcn_sched_barrier(0);
#pragma unroll
            for (int u = 0; u < 2; ++u) { const int t = 2 * tp + u;
                f32x4 d4 = {dsc, dsc, dsc, dsc};
                if (kind == 1) d4 = *(const LAS f32x4*)(decl + 16 * t + 4 * fq);
                f32x4 stv = S.st[t] * d4;
                stv = MFMA16(__builtin_bit_cast(bf16x8, fa[cur][2 * u]), bvs[0], stv);
                stv = MFMA16(__builtin_bit_cast(bf16x8, fa[cur][2 * u + 1]), bvs[1], stv);
                S.st[t] = stv; }
            __builtin_amdgcn_sched_barrier(0);
        }
#undef SCAN_LOADQ
#undef SCAN_LOADS
#undef SCAN_LOADK
        __syncthreads();
    }
}

template <int DK>
DI void phase_scan(const Params& p, lds_t lds, int kind) {
    const int G = gridDim.x, nround = (256 + G - 1) / G;
    for (int rd = 0; rd < nround; ++rd) {
        const int item = rd * G + blockIdx.x; const bool valid = item < 256;
        ScanState<DK> S;
#pragma unroll
        for (int t = 0; t < DK / 16; ++t) S.st[t] = (f32x4){0.f, 0.f, 0.f, 0.f};
        S.nreg = 0.f;
        if (valid) {
            LAS float* nl = (LAS float*)(lds + 64 * (DK * 2 + 16) + DK * 144 + 128 * 144 + 64 * 144) + 384;
            nl[otid()] = 0.f;
            __syncthreads();
            scan_steps<DK>(p, lds, kind, item, 0, 36, S);
        }
        xcd_barrier(p, lds);
        if (valid) scan_steps<DK>(p, lds, kind, item, 36, 68, S);
    }
}

DI void phase_p5(const Params& pin, int l, bool dummy) {
    const PP p = launder(pin);
    const int kind = lkind(l), lb = lbase(l);
    const int tid = otid(), wid = tid >> 6, lane = tid & 63;
    const float* hw = tin(p, lb + (kind == 0 ? 7 : (kind == 1 ? 6 : 5)));
    bf16_t* Og = (bf16_t*)(p.ws + OFF_RO); const bf16_t* Z = (const bf16_t*)(p.ws + OFF_R0); const bf16_t* OCB = (const bf16_t*)(p.ws + OFF_OCB);
    bf16_t* Yg = dummy ? (bf16_t*)(p.ws + OFF_RQ) : Og;
    const bool center = kind != 1;
    auto proc = [&](int row, const u32x4 (&ovv)[4], const u32x4 (&zvv)[4]) {
        const int b = row / LTOK, t = row - b * LTOK;
#pragma unroll
        for (int h = 0; h < 4; ++h) {
            const int col = h * 512 + lane * 8;
            const u32x4 ov = ovv[h];
            float o[8] = {lo_f(ov.x), hi_f(ov.x), lo_f(ov.y), hi_f(ov.y), lo_f(ov.z), hi_f(ov.z), lo_f(ov.w), hi_f(ov.w)};
            if (t < 256) { const u32x4 cv = *(const u32x4*)(OCB + (size_t)(b * 256 + t) * 2048 + col);
                o[0] += lo_f(cv.x); o[1] += hi_f(cv.x); o[2] += lo_f(cv.y); o[3] += hi_f(cv.y); o[4] += lo_f(cv.z); o[5] += hi_f(cv.z); o[6] += lo_f(cv.w); o[7] += hi_f(cv.w); }
            float mean = 0.f;
            if (center) { float sm = 0.f;
#pragma unroll
                for (int e = 0; e < 8; ++e) sm += o[e];
                mean = wsum(sm, lane) * (1.f / 512.f); }
            float q = 0.f;
#pragma unroll
            for (int e = 0; e < 8; ++e) { o[e] -= mean; q += o[e] * o[e]; }
            const float rstd = rsqrtf(wsum(q, lane) * (1.f / 512.f) + 1e-6f);
            const u32x4 zv = zvv[h];
            const float z[8] = {lo_f(zv.x), hi_f(zv.x), lo_f(zv.y), hi_f(zv.y), lo_f(zv.z), hi_f(zv.z), lo_f(zv.w), hi_f(zv.w)};
            const f32x4 w0 = *(const f32x4*)(hw + col), w1 = *(const f32x4*)(hw + col + 4);
            float y[8];
#pragma unroll
            for (int e = 0; e < 8; ++e) y[e] = o[e] * rstd * (e < 4 ? w0[e] : w1[e - 4]) * siluf(z[e]);
            u32x4 w; w.x = pack2(y[0], y[1]); w.y = pack2(y[2], y[3]); w.z = pack2(y[4], y[5]); w.w = pack2(y[6], y[7]);
            *(u32x4*)(Yg + (size_t)row * 2048 + col) = w;
        }
    };
    const int stride = gridDim.x * 8;
    for (int rowa = blockIdx.x * 8 + wid; rowa < MTOK; rowa += 2 * stride) {
        const int rowb0 = rowa + stride; const bool hb = rowb0 < MTOK; const int rowb = hb ? rowb0 : rowa;
        u32x4 oa[4], za[4], ob[4], zb[4];
#pragma unroll
        for (int h = 0; h < 4; ++h) { const int col = h * 512 + lane * 8;
            oa[h] = *(const u32x4*)(Og + (size_t)rowa * 2048 + col); za[h] = *(const u32x4*)(Z + (size_t)rowa * 2048 + col);
            ob[h] = *(const u32x4*)(Og + (size_t)rowb * 2048 + col); zb[h] = *(const u32x4*)(Z + (size_t)rowb * 2048 + col); }
        proc(rowa, oa, za);
        if (hb) proc(rowb, ob, zb);
    }
}

DI void phase_final(const Params& pin) {
    const PP p = launder(pin);
    const int tid = otid(), wid = tid >> 6, lane = tid & 63;
    const float* nw = tin(p, 37);
    f32x4 nw4[4];
#pragma unroll
    for (int i = 0; i < 4; ++i) nw4[i] = *(const f32x4*)(nw + lane * 4 + 256 * i);
    const int stride = gridDim.x * 8, NR = 8 * 4096;
    for (int rowa = blockIdx.x * 8 + wid; rowa < NR; rowa += 2 * stride) {
        const int rowb0 = rowa + stride; const bool hb = rowb0 < NR; const int rowb = hb ? rowb0 : rowa;
        float* hpa = p.out + (size_t)rowa * 1024; float* hpb = p.out + (size_t)rowb * 1024;
        f32x4 xa[4], xb[4]; float sa = 0.f, sb = 0.f;
#pragma unroll
        for (int i = 0; i < 4; ++i) { xa[i] = *(const f32x4*)(hpa + lane * 4 + 256 * i); xb[i] = *(const f32x4*)(hpb + lane * 4 + 256 * i); }
#pragma unroll
        for (int i = 0; i < 4; ++i) { sa += xa[i][0] * xa[i][0] + xa[i][1] * xa[i][1] + xa[i][2] * xa[i][2] + xa[i][3] * xa[i][3]; sb += xb[i][0] * xb[i][0] + xb[i][1] * xb[i][1] + xb[i][2] * xb[i][2] + xb[i][3] * xb[i][3]; }
        sa = wsum(sa, lane); sb = wsum(sb, lane);
        const float ra = rsqrtf(sa * (1.f / 1024.f) + 1e-6f), rb = rsqrtf(sb * (1.f / 1024.f) + 1e-6f);
#pragma unroll
        for (int i = 0; i < 4; ++i) { *(f32x4*)(hpa + lane * 4 + 256 * i) = xa[i] * ra * nw4[i]; if (hb) *(f32x4*)(hpb + lane * 4 + 256 * i) = xb[i] * rb * nw4[i]; }
    }
}

__global__ void __launch_bounds__(512, 2) fwd_megakernel(Params p) {
    extern __shared__ __attribute__((aligned(16))) unsigned char shm[];
    lds_t lds = (lds_t)shm;
    cg::grid_group grid = cg::this_grid();
    const int G = gridDim.x, bid = blockIdx.x;
    volatile LAS unsigned* xst = (volatile LAS unsigned*)(lds + LDS_BYTES - 16);
    if (threadIdx.x == 0) { xst[0] = 0u; xst[1] = 0u; }
    __syncthreads();
    (void)xcd_barrier_post((unsigned*)(p.ws + OFF_BAR), xst);
    for (int rep = 0; rep < REP_P0; ++rep) phase0(p, lds);
    grid.sync();
    for (int l = 0; l < 4; ++l) {
        const int kind = lkind(l);
        const int nqk = kind == 1 ? 1024 : 2048;
        for (int rep = 0; rep < REP_P1F; ++rep) phase_p1(p, lds, l, true);
        xcd_barrier(p, lds);
        {
            if (kind == 0) { for (int it = (bid + G - 128 % G) % G; it < 32; it += G) mlstm_chain(p, lds, it >> 2, it & 3); }
            const PP q = launder(p); const bf16_t* WT = (const bf16_t*)(q.ws + off_wt(l));
            pg8::Gemm g{(const bf16_t*)(q.ws + OFF_RQ), WT, MTOK, nqk, 1024};
            pg8::StaticOrder S; S.init(g.M, g.N, G, bid);
            pg8::EpiBf16 E{(bf16_t*)(q.ws + OFF_RO), nqk};
            for (int rep = 0; rep < REP_GEMM; ++rep) pg8::gemm_phase(lds, g, S, E);
        }
        {
            const PP q = launder(p); const bf16_t* WT = (const bf16_t*)(q.ws + off_wt(l));
            pg8::Gemm g{WT + (size_t)nqk * 1024, (const bf16_t*)(q.ws + OFF_RQ), 2048, MTOK, 1024};
            pg8::StaticOrder S; S.init(g.M, g.N, G, (bid + G - (kind == 1 ? 128 : 64) % G) % G);
            pg8::EpiBf16 E{(bf16_t*)(q.ws + OFF_R0), MTOK};
            for (int rep = 0; rep < REP_GEMM; ++rep) pg8::gemm_phase(lds, g, S, E);
        }
        xcd_barrier(p, lds);
        for (int rep = 0; rep < REP_P3; ++rep) { if (kind == 0) phase_p3<256, 0>(p, lds, l); else if (kind == 1) phase_p3<128, 1>(p, lds, l); else phase_p3<256, 2>(p, lds, l); }
        xcd_barrier(p, lds);
        for (int rep = 0; rep < REP_SCAN; ++rep) { if (rep) xcd_barrier(p, lds); if (kind == 1) phase_scan<128>(p, lds, kind); else phase_scan<256>(p, lds, kind); }
        xcd_barrier(p, lds);
        for (int rep = 0; rep < REP_P1; ++rep) phase_p1(p, lds, l, false);
        xcd_barrier(p, lds);
        {
            const PP q = launder(p); const bf16_t* WT = (const bf16_t*)(q.ws + off_wt(l));
            pg8::Gemm g{(const bf16_t*)(q.ws + OFF_RQ), WT + (size_t)(nqk + 2048) * 1024, MTOK, 2048, 1024};
            pg8::StaticOrder S; S.init(g.M, g.N, G, bid, l == 3 ? 1 : 0);
#ifdef FUSE_GATE
            pg8::EpiGate E{(bf16_t*)(q.ws + OFF_RO), (const bf16_t*)(q.ws + OFF_OCB), (const f32x2*)(q.ws + OFF_STATS), tin(q, lbase(l) + (kind == 0 ? 7 : (kind == 1 ? 6 : 5)))};
            pg8::gemm_phase(lds, g, S, E);
        }
        xcd_barrier(p, lds);
#else
            pg8::EpiBf16 E{(bf16_t*)(q.ws + OFF_R0), 2048};
            pg8::gemm_phase(lds, g, S, E);
        }
        if (l < 3) weights_prep(p, lds, l + 1, G >= 128 ? 64 : 0);
        xcd_barrier(p, lds);
        for (int rep = 0; rep < REP_P5D; ++rep) phase_p5(p, l, true);
        phase_p5(p, l, false);
        xcd_barrier(p, lds);
#endif
        {
            const PP q = launder(p);
            pg8::Gemm g{(const bf16_t*)(q.ws + OFF_RO), (const bf16_t*)(q.ws + off_wo(l)), MTOK, 1024, 2048};
            pg8::StaticOrder S; S.init(g.M, g.N, G, bid, l == 3 ? 1 : 0);
            { pg8::EpiNull E0{(float*)(q.ws + OFF_STATS)}; for (int rep = 0; rep < REP_OUTD; ++rep) pg8::gemm_phase(lds, g, S, E0); }
            pg8::EpiRes E{q.out, (float*)(q.ws + OFF_HCTX), (const float*)(q.ws + OFF_ADA) + (size_t)l * 9 * 3072, l == 3 ? 1 : 0, l == 0 ? tin(q, 0) : nullptr, l == 0 ? tin(q, 2) : nullptr};
            pg8::gemm_phase(lds, g, S, E);
        }
        xcd_barrier(p, lds);
    }
    for (int rep = 0; rep < REP_SYNC; ++rep) xcd_barrier(p, lds);
    phase_final(p);
}

extern "C" void kernel_launch(void* const* d_in, const int* in_sizes, int n_in, void* d_out, int out_size, void* d_ws, size_t ws_size, hipStream_t stream) {
    static int grid = 0;
    if (grid == 0) {
        if (n_in != 38 || ws_size < WS_END) { fprintf(stderr, "kernel_launch: unexpected n_in %d or ws_size %zu (< %zu)\n", n_in, ws_size, (size_t)WS_END); grid = -1; return; }
        int dev = 0, cus = 0, per_cu = 0;
        hipGetDevice(&dev);
        hipDeviceGetAttribute(&cus, hipDeviceAttributeMultiprocessorCount, dev);
        if (hipFuncSetAttribute((const void*)fwd_megakernel, hipFuncAttributeMaxDynamicSharedMemorySize, LDS_BYTES) != hipSuccess) { fprintf(stderr, "hipFuncSetAttribute failed\n"); grid = -1; return; }
        hipOccupancyMaxActiveBlocksPerMultiprocessor(&per_cu, (const void*)fwd_megakernel, 512, LDS_BYTES);
        if (per_cu < 1) per_cu = 1;
        (void)hipGetLastError();
        grid = cus * per_cu;
        if (grid > 256) grid = 256;
    }
    if (grid < 0) return;
    (void)hipMemsetAsync((unsigned char*)d_ws + OFF_BAR, 0, 16384, stream);
    Params p{};
    for (int i = 0; i < 38; ++i) p.in[i] = (const float*)d_in[i];
    p.out = (float*)d_out; p.ws = (unsigned char*)d_ws;
    void* args[] = {&p};
    hipError_t e = hipLaunchCooperativeKernel((const void*)fwd_megakernel, dim3(grid), dim3(512), args, LDS_BYTES, stream);
    if (e != hipSuccess) fprintf(stderr, "cooperative launch failed: %s (grid %d)\n", hipGetErrorString(e), grid);
}
```

```cpp
#include <hip/hip_runtime.h>
#include <hip/hip_cooperative_groups.h>
#include <cstdio>
namespace cg = cooperative_groups;

#define LAS __attribute__((address_space(3)))
#define DI __device__ __forceinline__
typedef unsigned short bf16_t;
typedef short bf16x8 __attribute__((ext_vector_type(8)));
typedef short s16x4 __attribute__((ext_vector_type(4)));
typedef float f32x4 __attribute__((ext_vector_type(4)));
typedef float f32x2 __attribute__((ext_vector_type(2)));
typedef unsigned u32x4 __attribute__((ext_vector_type(4)));
typedef unsigned u32x2 __attribute__((ext_vector_type(2)));
typedef __bf16 bfv2 __attribute__((ext_vector_type(2)));
typedef LAS unsigned char* lds_t;

constexpr int MTOK = 34816, LTOK = 4352, NCHK = 68;
constexpr size_t SZ_BIG = (size_t)MTOK * 2048 * 2;
constexpr size_t OFF_R0 = 0;
constexpr size_t OFF_RO = SZ_BIG;
constexpr size_t OFF_RQ = 2 * SZ_BIG;
constexpr size_t OFF_RK = OFF_RQ + SZ_BIG / 2;
constexpr size_t OFF_RS = OFF_RK + SZ_BIG / 2;
constexpr size_t SZ_S = (size_t)2 * 8 * 4 * 68 * 4096 * 2;
constexpr size_t OFF_HCTX = OFF_RS + SZ_S;
constexpr size_t OFF_WT = OFF_HCTX + (size_t)8 * 256 * 1024 * 4;
constexpr size_t OFF_WO = OFF_WT + (size_t)6144 * 1024 * 2;
constexpr size_t OFF_GATES = OFF_WO + (size_t)1024 * 2048 * 2;
constexpr size_t SZ_SCAL = (size_t)2 * 8 * 4 * LTOK * 4;
constexpr size_t OFF_SA = OFF_GATES + (size_t)MTOK * 32 * 4;
constexpr size_t OFF_SC = OFF_SA + SZ_SCAL;
constexpr size_t OFF_SR = OFF_SC + SZ_SCAL;
constexpr size_t OFF_SF = OFF_SR + SZ_SCAL;
constexpr size_t OFF_SK = OFF_SF + SZ_SCAL;
constexpr size_t OFF_RSUM = OFF_SK + SZ_SCAL;
constexpr size_t OFF_DECS = OFF_RSUM + SZ_SCAL;
constexpr size_t OFF_DEC = OFF_DECS + 32768;
constexpr size_t OFF_ADA = OFF_DEC + (size_t)2 * 8 * 4 * 68 * 128 * 4;
constexpr size_t OFF_OCB = OFF_ADA + (size_t)4 * 9 * 3072 * 4;
constexpr size_t OFF_TAB = OFF_OCB + (size_t)8 * 256 * 2048 * 2;
constexpr size_t OFF_BAR = OFF_TAB + 4096;
constexpr size_t OFF_STATS = OFF_BAR + 16384;
constexpr size_t OFF_WT2 = OFF_STATS + (size_t)MTOK * 4 * 8;
constexpr size_t OFF_WO2 = OFF_WT2 + (size_t)6144 * 1024 * 2;
constexpr size_t WS_END = OFF_WO2 + (size_t)1024 * 2048 * 2;
constexpr int LDS_BYTES = 147456;

#ifndef REP_GEMM
#define REP_GEMM 1
#endif
#ifndef REP_SCAN
#define REP_SCAN 1
#endif
#ifndef REP_P3
#define REP_P3 1
#endif
#ifndef REP_SYNC
#define REP_SYNC 0
#endif
#ifndef REP_P5D
#define REP_P5D 0
#endif
#ifndef REP_OUTD
#define REP_OUTD 0
#endif
#ifndef REP_P0
#define REP_P0 1
#endif
#ifndef REP_P1F
#define REP_P1F 1
#endif
#ifndef REP_P1
#define REP_P1 1
#endif
struct Params { const float* in[38]; float* out; unsigned char* ws; };

DI int otid() { int t = threadIdx.x; asm volatile("" : "+v"(t)); return t; }
DI int obid() { int t = blockIdx.x; asm volatile("" : "+s"(t)); return t; }
struct PP { float* out; unsigned char* ws; };
DI PP launder(const Params& p) { PP q; q.out = p.out; q.ws = p.ws; asm volatile("" : "+s"(q.out), "+s"(q.ws)); return q; }
DI PP launder(const PP& p) { PP q = p; asm volatile("" : "+s"(q.out), "+s"(q.ws)); return q; }
DI size_t off_wt(int l) { return (l & 1) ? OFF_WT2 : OFF_WT; }
DI size_t off_wo(int l) { return (l & 1) ? OFF_WO2 : OFF_WO; }
DI const float* tin(const PP& p, int i) { return ((const float* const*)(p.ws + OFF_TAB))[i]; }
DI float bf2f(unsigned b) { return __uint_as_float(b << 16); }
DI unsigned pack2(float a, float b) { f32x2 f = {a, b}; bfv2 r = __builtin_convertvector(f, bfv2); return __builtin_bit_cast(unsigned, r); }
DI bf16_t f2bf(float a) { return (bf16_t)(pack2(a, 0.f) & 0xffffu); }
DI float lo_f(unsigned w) { return __uint_as_float(w << 16); }
DI float hi_f(unsigned w) { return __uint_as_float(w & 0xffff0000u); }
DI float dot2(unsigned a, unsigned b, float c) { return __builtin_amdgcn_fdot2_f32_bf16(__builtin_bit_cast(bfv2, a), __builtin_bit_cast(bfv2, b), c, false); }
DI int swz16x32(int ob) { return ob ^ (((ob >> 9) & 1) << 5); }
DI float siluf(float v) { return v / (1.f + __expf(-v)); }
DI float logsig(float x) { return fminf(x, 0.f) - __logf(1.f + __expf(-fabsf(x))); }
DI int lbase(int l) { return l == 0 ? 4 : (l == 1 ? 13 : (l == 2 ? 21 : 28)); }
DI int lkind(int l) { return l == 1 ? 1 : (l == 2 ? 2 : 0); }
DI float shx(float v, int mask, int lane) { return __int_as_float(__builtin_amdgcn_ds_bpermute((lane ^ mask) << 2, __float_as_int(v))); }
DI float shup(float v, int o, int lane) { return __int_as_float(__builtin_amdgcn_ds_bpermute((lane - o) << 2, __float_as_int(v))); }
DI float dpp_add(float v, const int ctrl) { return v; }
#define DPP_ADD(v, ctrl) ((v) + __int_as_float(__builtin_amdgcn_update_dpp(0, __float_as_int(v), (ctrl), 0xf, 0xf, true)))
DI float wsum(float v, int lane) {
    (void)lane;
    v = DPP_ADD(v, 0xB1);
    v = DPP_ADD(v, 0x4E);
    v = DPP_ADD(v, 0x141);
    v = DPP_ADD(v, 0x140);
    const int vi = __float_as_int(v);
    const float r0 = __int_as_float(__builtin_amdgcn_readlane(vi, 0)), r1 = __int_as_float(__builtin_amdgcn_readlane(vi, 16));
    const float r2 = __int_as_float(__builtin_amdgcn_readlane(vi, 32)), r3 = __int_as_float(__builtin_amdgcn_readlane(vi, 48));
    return (r0 + r1) + (r2 + r3);
}
DI const float* hrow(const PP& p, int row, int l) {
    const int b = row / LTOK, t = row - b * LTOK;
    if (l == 0) return t < 256 ? tin(p, 2) + (size_t)(b * 256 + t) * 1024 : tin(p, 0) + (size_t)(b * 4096 + t - 256) * 1024;
    return t < 256 ? (const float*)(p.ws + OFF_HCTX) + (size_t)(b * 256 + t) * 1024 : p.out + (size_t)(b * 4096 + t - 256) * 1024;
}

#define XB_TMO      128
#define XB_XCNT(j)  (256  + 64 * (j))
#define XB_XSUB(j)  (1280 + 64 * (j))
#define XB_XGEN(j)  (2304 + 64 * (j))
#define XB_TOP      3328
#define XB_TOPGEN   3392
#define XCD_BAR_WORDS 3456
#define XB_SPIN_CAP (1u << 22)
DI unsigned xb_ld(unsigned* p)              { return __hip_atomic_load(p, __ATOMIC_RELAXED, __HIP_MEMORY_SCOPE_AGENT); }
DI unsigned xb_add(unsigned* p, unsigned v) { return __hip_atomic_fetch_add(p, v, __ATOMIC_RELAXED, __HIP_MEMORY_SCOPE_AGENT); }
DI unsigned xb_xcc_id() { return (unsigned)__builtin_amdgcn_s_getreg((3 << 11) | 20) & 0xFu; }
#define XB_SPIN(cond, bar) do { unsigned _sp = 0; while (cond) { __builtin_amdgcn_s_sleep(1); \
    if ((++_sp & 255u) == 0u) { if (xb_ld(&(bar)[XB_TMO])) break; if (_sp > XB_SPIN_CAP) { atomicAdd(&(bar)[XB_TMO], 1u); break; } } } } while (0)
struct XcdBarrier { unsigned* bar; unsigned x; volatile LAS unsigned* st; };
DI XcdBarrier xcd_barrier_post(unsigned* bar, volatile LAS unsigned* st) {
    XcdBarrier b; b.bar = bar; b.x = xb_xcc_id(); b.st = st;
    if (threadIdx.x == 0) (void)xb_add(&bar[XB_XCNT(b.x)], 1u);
    return b;
}
DI void xcd_barrier_complete(unsigned* bar, unsigned x, unsigned& nloc, unsigned& nx) {
    const unsigned G = gridDim.x * gridDim.y * gridDim.z;
    unsigned sum, cnt, mine, sp = 0u;
    for (;;) {
        sum = 0u; cnt = 0u; mine = 0u;
#pragma unroll
        for (unsigned j = 0; j < 16; ++j) { const unsigned c = xb_ld(&bar[XB_XCNT(j)]); sum += c; cnt += (c > 0u) ? 1u : 0u; mine = (j == x) ? c : mine; }
        if (sum == G) break;
        __builtin_amdgcn_s_sleep(1);
        if ((++sp & 255u) == 0u) { if (xb_ld(&bar[XB_TMO])) break; if (sp > XB_SPIN_CAP) { atomicAdd(&bar[XB_TMO], 1u); break; } }
    }
    nloc = mine > 0u ? mine : 1u; nx = cnt > 0u ? cnt : 1u;
}
DI void xcd_barrier(const Params& pin, lds_t lds) {
    const PP p = launder(pin);
    XcdBarrier b; b.bar = (unsigned*)(p.ws + OFF_BAR); b.st = (volatile LAS unsigned*)(lds + LDS_BYTES - 16);
    asm volatile("s_waitcnt vmcnt(0)" ::: "memory");
    __syncthreads();
    if (threadIdx.x == 0) {
        unsigned* bar = b.bar; b.x = xb_xcc_id();
        __builtin_amdgcn_s_waitcnt(0);
        unsigned nloc = b.st[0], nx = b.st[1];
        if (nloc == 0u) { xcd_barrier_complete(bar, b.x, nloc, nx); b.st[0] = nloc; b.st[1] = nx; }
        const unsigned old = xb_add(&bar[XB_XSUB(b.x)], 1u);
        const unsigned gen = old / nloc;
        if (old + 1u == (gen + 1u) * nloc) {
            __builtin_amdgcn_fence(__ATOMIC_RELEASE, "agent");
            asm volatile("s_waitcnt vmcnt(0)" ::: "memory");
            const unsigned og = xb_add(&bar[XB_TOP], 1u);
            const unsigned tg = og / nx;
            if (og + 1u == (tg + 1u) * nx) xb_add(&bar[XB_TOPGEN], 1u);
            else XB_SPIN(xb_ld(&bar[XB_TOPGEN]) == tg, bar);
            __builtin_amdgcn_fence(__ATOMIC_ACQUIRE, "agent");
            xb_add(&bar[XB_XGEN(b.x)], 1u);
            asm volatile("s_waitcnt vmcnt(0)" ::: "memory");
        } else {
            XB_SPIN(xb_ld(&bar[XB_XGEN(b.x)]) == gen, bar);
            __builtin_amdgcn_fence(__ATOMIC_ACQUIRE, "agent");
            asm volatile("s_waitcnt vmcnt(0)" ::: "memory");
        }
    }
    __syncthreads();
}

#define MFMA16(a, b, c) __builtin_amdgcn_mfma_f32_16x16x32_bf16((a), (b), (c), 0, 0, 0)

namespace pg8 {
constexpr int BM = 256, BK = 64, HALF = 128, HTB = HALF * BK * 2, NXCD = 8, WGM = 8;
DI int lds_byte(int r, int c) { const int st = (r >> 4) * 2 + (c >> 5), rr = r & 15, cc = c & 31, ob = rr * 64 + cc * 2; return st * 1024 + (ob ^ (((ob >> 9) & 1) << 5)); }
DI void stage_rc(int b, int& R, int& C) { const int st = b / 1024, sb = b % 1024, swz = sb ^ (((sb >> 9) & 1) << 5); R = (st >> 1) * 16 + swz / 64; C = (st & 1) * 32 + (swz % 64) / 2; }
DI int perm32(int rho) { const int n = rho >> 4, i = rho & 15; return 8 * (i >> 2) + 4 * n + (i & 3); }
struct Unit { int pm, pn; };
struct Gemm { const bf16_t* A; const bf16_t* Bt; int M, N, K; };
struct StaticOrder {
    int nM, nN, nwg, G, c, skipctx;
    DI void init(int M, int N, int G_, int c_, int skipctx_ = 0) { skipctx = skipctx_; nM = skipctx_ ? 128 : M / BM; nN = N / BM; nwg = nM * nN; G = G_; c = c_; }
    DI bool next(int i, Unit& u) const {
        const long L = (long)i * G + c; if (L >= nwg) return false;
        int wgid = (int)L; { const int q = nwg / NXCD, r = nwg % NXCD, xcd = wgid % NXCD, off = wgid / NXCD; wgid = (xcd < r ? xcd * (q + 1) : r * (q + 1) + (xcd - r) * q) + off; }
        const int nig = WGM * nN, gid = wgid / nig, fm = gid * WGM, gsz = (nM - fm) < WGM ? (nM - fm) : WGM;
        u.pm = fm + ((wgid % nig) % gsz); u.pn = (wgid % nig) / gsz; if (skipctx) u.pm += u.pm / 16 + 1; return true;
    }
};

template <class Epi>
DI void gemm_phase(lds_t lds, const Gemm g, const StaticOrder& S, const Epi& E) {
    const int tid = otid(), wid = __builtin_amdgcn_readfirstlane(tid >> 6), lane = tid & 63, wr = wid >> 2, wc = wid & 3, fr = lane & 15, fq = lane >> 4;
    const int K = g.K, nt = K / BK;
    unsigned voffA[2], voffB[2];
#pragma unroll
    for (int i = 0; i < 2; ++i) { int R, C; stage_rc(tid * 16 + i * 8192, R, C); const int Rb = Epi::PERM ? ((R & ~31) + perm32(R & 31)) : R;
        voffA[i] = (unsigned)(R * K + C) * 2u; voffB[i] = (unsigned)(Rb * K + C) * 2u; }
    const size_t kstep = (size_t)(BK * 2);
    const size_t hstep = (size_t)HALF * K * 2;
    const size_t tstep = 2 * hstep;
    const unsigned ldsw = (unsigned)wid * 1024u;
    const int aoff = lds_byte(wr * 64 + fr, fq * 8), boff = lds_byte(wc * 32 + fr, fq * 8);
#define PG8_SA(b, h) (((b) * 2 + (h)) * HTB)
#define PG8_SB(b, h) ((4 + (b) * 2 + (h)) * HTB)
#define PG8_STAGE(bufoff, gbase, voff) do { _Pragma("unroll") for (int _i = 0; _i < 2; ++_i) \
        __builtin_amdgcn_global_load_lds((const unsigned*)((const char*)(gbase) + (voff)[_i]), (LAS unsigned*)(lds + (bufoff) + ldsw + _i * 8192), 16, 0, 0); } while (0)
#define PG8_LDA(dst, b, h) do { _Pragma("unroll") for (int m = 0; m < 4; ++m) _Pragma("unroll") for (int k = 0; k < 2; ++k) dst[m][k] = *(const LAS bf16x8*)(lds + PG8_SA(b, h) + aoff + m * 2048 + k * 1024); } while (0)
#define PG8_LDB(dst, b, h) do { _Pragma("unroll") for (int n = 0; n < 2; ++n) _Pragma("unroll") for (int k = 0; k < 2; ++k) dst[n][k] = *(const LAS bf16x8*)(lds + PG8_SB(b, h) + boff + n * 2048 + k * 1024); } while (0)
#define PG8_MMA(ai, bj, At, Bt) do { __builtin_amdgcn_s_setprio(1); _Pragma("unroll") for (int m = 0; m < 4; ++m) _Pragma("unroll") for (int n = 0; n < 2; ++n) _Pragma("unroll") for (int k = 0; k < 2; ++k) \
        acc[ai][bj][m][n] = __builtin_amdgcn_mfma_f32_16x16x32_bf16(Bt[n][k], At[m][k], acc[ai][bj][m][n], 0, 0, 0); __builtin_amdgcn_s_setprio(0); } while (0)
#define PG8_WAIT_V(n) asm volatile("s_waitcnt vmcnt(" #n ")" ::: "memory")
#define PG8_WAIT_L(n) asm volatile("s_waitcnt lgkmcnt(" #n ")" ::: "memory")
#define PG8_BAR __builtin_amdgcn_s_barrier()
#define PG8_SCHED __builtin_amdgcn_sched_barrier(0)
    Unit cur, nxt; int ui = 0;
    if (!S.next(0, cur)) return;
#ifdef GEMM_STAGGER
    if ((blockIdx.x >> 3) & 1) { const unsigned long long t0 = __builtin_amdgcn_s_memrealtime(); while (__builtin_amdgcn_s_memrealtime() - t0 < GEMM_STAGGER) __builtin_amdgcn_s_sleep(8); }
#endif
    f32x4 acc[2][2][4][2];
#pragma unroll
    for (int a = 0; a < 2; ++a)
#pragma unroll
        for (int b = 0; b < 2; ++b)
#pragma unroll
            for (int m = 0; m < 4; ++m)
#pragma unroll
                for (int n = 0; n < 2; ++n) acc[a][b][m][n] = (f32x4){0.f, 0.f, 0.f, 0.f};
    bf16x8 At[4][2], B0[2][2], B1[2][2];
    const char* cA = (const char*)g.A + (size_t)cur.pm * tstep; const char* cB = (const char*)g.Bt + (size_t)cur.pn * tstep;
    PG8_STAGE(PG8_SB(0, 0), cB, voffB); PG8_STAGE(PG8_SA(0, 0), cA, voffA); PG8_STAGE(PG8_SB(0, 1), cB + hstep, voffB); PG8_STAGE(PG8_SA(0, 1), cA + hstep, voffA);
    if (wr == 1) PG8_BAR;
    PG8_WAIT_V(4); PG8_BAR;
    PG8_STAGE(PG8_SB(1, 0), cB + kstep, voffB); PG8_STAGE(PG8_SA(1, 0), cA + kstep, voffA); PG8_STAGE(PG8_SB(1, 1), cB + hstep + kstep, voffB);
    PG8_WAIT_V(6); PG8_BAR;
    for (;;) {
        const bool has_next = S.next(ui + 1, nxt);
        const char* nA = has_next ? (const char*)g.A + (size_t)nxt.pm * tstep : cA; const char* nB = has_next ? (const char*)g.Bt + (size_t)nxt.pn * tstep : cB;
        for (int t = 0; t < nt; t += 2) {
            const bool last = (t == nt - 2);
            const char* a1 = cA + (size_t)(t + 1) * kstep;
            const char* a2 = last ? nA : cA + (size_t)(t + 2) * kstep; const char* b2 = last ? nB : cB + (size_t)(t + 2) * kstep;
            const char* a3 = a2 + kstep; const char* b3 = b2 + kstep;
            PG8_LDB(B0, 0, 0); PG8_SCHED; PG8_LDA(At, 0, 0); PG8_STAGE(PG8_SA(1, 1), a1 + hstep, voffA);
            PG8_WAIT_L(8); PG8_BAR; PG8_WAIT_L(0); PG8_MMA(0, 0, At, B0); PG8_BAR; PG8_SCHED;
            PG8_LDB(B1, 0, 1); PG8_STAGE(PG8_SB(0, 0), b2, voffB);
            PG8_BAR; PG8_WAIT_L(0); PG8_MMA(0, 1, At, B1); PG8_BAR;
            PG8_LDA(At, 0, 1); PG8_STAGE(PG8_SA(0, 0), a2, voffA);
            PG8_BAR; PG8_WAIT_L(0); PG8_MMA(1, 0, At, B0); PG8_BAR; PG8_SCHED;
            PG8_STAGE(PG8_SB(0, 1), b2 + hstep, voffB);
            PG8_WAIT_V(6); PG8_BAR; PG8_MMA(1, 1, At, B1); PG8_BAR;
            PG8_LDB(B0, 1, 0); PG8_SCHED; PG8_LDA(At, 1, 0); PG8_STAGE(PG8_SA(0, 1), a2 + hstep, voffA);
            PG8_WAIT_L(8); PG8_BAR; PG8_WAIT_L(0); PG8_MMA(0, 0, At, B0); PG8_BAR; PG8_SCHED;
            PG8_LDB(B1, 1, 1); PG8_STAGE(PG8_SB(1, 0), b3, voffB);
            PG8_BAR; PG8_WAIT_L(0); PG8_MMA(0, 1, At, B1); PG8_BAR;
            PG8_LDA(At, 1, 1); PG8_STAGE(PG8_SA(1, 0), a3, voffA);
            PG8_BAR; PG8_WAIT_L(0); PG8_MMA(1, 0, At, B0); PG8_BAR; PG8_SCHED;
            PG8_STAGE(PG8_SB(1, 1), b3 + hstep, voffB);
            PG8_WAIT_V(6); PG8_BAR; PG8_MMA(1, 1, At, B1); PG8_BAR;
        }
        E(acc, cur, wr, wc, fr, fq);
        if (!has_next) break;
#pragma unroll
        for (int a = 0; a < 2; ++a)
#pragma unroll
            for (int b = 0; b < 2; ++b)
#pragma unroll
                for (int m = 0; m < 4; ++m)
#pragma unroll
                    for (int n = 0; n < 2; ++n) acc[a][b][m][n] = (f32x4){0.f, 0.f, 0.f, 0.f};
        cur = nxt; cA = nA; cB = nB; ++ui;
    }
    PG8_WAIT_V(0);
    if (wr == 0) PG8_BAR;
    PG8_BAR;
#undef PG8_SA
#undef PG8_SB
#undef PG8_STAGE
#undef PG8_LDA
#undef PG8_LDB
#undef PG8_MMA
#undef PG8_WAIT_V
#undef PG8_WAIT_L
#undef PG8_BAR
#undef PG8_SCHED
}

struct EpiBf16 {
    static constexpr bool PERM = true;
    bf16_t* O; int ldc;
    DI void operator()(const f32x4 (&acc)[2][2][4][2], const Unit& u, int wr, int wc, int fr, int fq) const {
        const int row0 = u.pm * BM + wr * 64 + fr, col0 = u.pn * BM + wc * 32 + 8 * fq;
#pragma unroll
        for (int ai = 0; ai < 2; ++ai)
#pragma unroll
            for (int m = 0; m < 4; ++m) { bf16_t* rowp = O + (size_t)(row0 + ai * HALF + m * 16) * ldc + col0;
#pragma unroll
                for (int bj = 0; bj < 2; ++bj) { const f32x4 v0 = acc[ai][bj][m][0], v1 = acc[ai][bj][m][1];
                    u32x4 w; w.x = pack2(v0[0], v0[1]); w.y = pack2(v0[2], v0[3]); w.z = pack2(v1[0], v1[1]); w.w = pack2(v1[2], v1[3]);
                    *(u32x4*)(rowp + bj * HALF) = w; } }
    }
};
struct EpiNull { static constexpr bool PERM = false; float* sink;
    DI void operator()(const f32x4 (&acc)[2][2][4][2], const Unit& u, int wr, int wc, int fr, int fq) const { if (acc[0][0][0][0][0] == 12345.678f) sink[0] = 1.f; } };
struct EpiRes {
    static constexpr bool PERM = false;
    float* out; float* hctx; const float* ada_l; int last; const float* xin; const float* cin;
    DI void operator()(const f32x4 (&acc)[2][2][4][2], const Unit& u, int wr, int wc, int fr, int fq) const {
        const int b = u.pm / 17, tt = u.pm % 17;
        float* base; const float* src; const float* g;
        if (tt == 0) { if (last) return; base = hctx + (size_t)b * 256 * 1024; src = cin ? cin + (size_t)b * 256 * 1024 : base; g = ada_l + 8 * 3072 + 2048; }
        else { const size_t o_ = ((size_t)b * 4096 + (size_t)(tt - 1) * 256) * 1024; base = out + o_; src = xin ? xin + o_ : base; g = ada_l + b * 3072 + 2048; }
        const int col0 = u.pn * BM + wc * 32 + 4 * fq;
        f32x4 gv[2][2];
#pragma unroll
        for (int bj = 0; bj < 2; ++bj)
#pragma unroll
            for (int n = 0; n < 2; ++n) gv[bj][n] = *(const f32x4*)(g + col0 + bj * HALF + n * 16);
#pragma unroll
        for (int ai = 0; ai < 2; ++ai) {
            f32x4 hv[4][2][2];
#pragma unroll
            for (int m = 0; m < 4; ++m) { const size_t ro_ = (size_t)(wr * 64 + fr + ai * HALF + m * 16) * 1024 + col0;
#pragma unroll
                for (int bj = 0; bj < 2; ++bj)
#pragma unroll
                    for (int n = 0; n < 2; ++n) hv[m][bj][n] = *(const f32x4*)(src + ro_ + bj * HALF + n * 16); }
#pragma unroll
            for (int m = 0; m < 4; ++m) { const size_t ro_ = (size_t)(wr * 64 + fr + ai * HALF + m * 16) * 1024 + col0;
#pragma unroll
                for (int bj = 0; bj < 2; ++bj)
#pragma unroll
                    for (int n = 0; n < 2; ++n) *(f32x4*)(base + ro_ + bj * HALF + n * 16) = hv[m][bj][n] + gv[bj][n] * acc[ai][bj][m][n]; }
        }
    }
};
struct EpiGate {
    static constexpr bool PERM = true;
    bf16_t* O; const bf16_t* OCB; const f32x2* stats; const float* hw;
    DI void operator()(const f32x4 (&acc)[2][2][4][2], const Unit& u, int wr, int wc, int fr, int fq) const {
        const int row0 = u.pm * BM + wr * 64 + fr, col0 = u.pn * BM + wc * 32 + 8 * fq;
        const int b = u.pm / 17, tt = u.pm % 17;
        f32x4 hwv[2][2];
#pragma unroll
        for (int bj = 0; bj < 2; ++bj) { hwv[bj][0] = *(const f32x4*)(hw + col0 + bj * HALF); hwv[bj][1] = *(const f32x4*)(hw + col0 + bj * HALF + 4); }
#pragma unroll
        for (int ai = 0; ai < 2; ++ai) {
            u32x4 ov[4][2]; f32x2 st[4][2];
#pragma unroll
            for (int m = 0; m < 4; ++m)
#pragma unroll
                for (int bj = 0; bj < 2; ++bj) { const int row = row0 + ai * HALF + m * 16, col = col0 + bj * HALF;
                    ov[m][bj] = *(const u32x4*)(O + (size_t)row * 2048 + col); st[m][bj] = stats[(size_t)row * 4 + (col >> 9)]; }
#pragma unroll
            for (int m = 0; m < 4; ++m)
#pragma unroll
                for (int bj = 0; bj < 2; ++bj) { const int row = row0 + ai * HALF + m * 16, col = col0 + bj * HALF;
                    const u32x4 v = ov[m][bj];
                    float o[8] = {lo_f(v.x), hi_f(v.x), lo_f(v.y), hi_f(v.y), lo_f(v.z), hi_f(v.z), lo_f(v.w), hi_f(v.w)};
                    if (tt == 0) { const u32x4 cv = *(const u32x4*)(OCB + (size_t)(b * 256 + (row - u.pm * BM)) * 2048 + col);
                        o[0] += lo_f(cv.x); o[1] += hi_f(cv.x); o[2] += lo_f(cv.y); o[3] += hi_f(cv.y); o[4] += lo_f(cv.z); o[5] += hi_f(cv.z); o[6] += lo_f(cv.w); o[7] += hi_f(cv.w); }
                    const float mean = st[m][bj].x, rstd = st[m][bj].y;
                    const f32x4 z0 = acc[ai][bj][m][0], z1 = acc[ai][bj][m][1];
                    float y[8];
#pragma unroll
                    for (int e = 0; e < 4; ++e) { y[e] = (o[e] - mean) * rstd * hwv[bj][0][e] * siluf(z0[e]); y[4 + e] = (o[4 + e] - mean) * rstd * hwv[bj][1][e] * siluf(z1[e]); }
                    u32x4 w; w.x = pack2(y[0], y[1]); w.y = pack2(y[2], y[3]); w.z = pack2(y[4], y[5]); w.w = pack2(y[6], y[7]);
                    *(u32x4*)(O + (size_t)row * 2048 + col) = w; }
        }
    }
};
}

DI void phase0(const Params& p, lds_t lds) {
    const int tid = otid(), bid = obid(), G = gridDim.x;
    if (tid == 0) {
#pragma unroll
        for (int i = 0; i < 38; ++i) ((const float**)(p.ws + OFF_TAB))[i] = p.in[i]; }
    LAS float* sc = (LAS float*)lds;
    LAS float* red = sc + 9 * 1024;
    float* ada = (float*)(p.ws + OFF_ADA);
    bool loaded = false;
    for (int it = bid; it < 192; it += G) {
        if (!loaded) { for (int i = tid; i < 9 * 1024; i += 512) { const float v = i < 8192 ? p.in[1][i] : p.in[3][i - 8192]; sc[i] = siluf(v); } __syncthreads(); loaded = true; }
        const int l = it / 48, cb = it % 48, cl = tid & 63, kp = tid >> 6, col = cb * 64 + cl;
        const float* aw = l == 0 ? p.in[5] : (l == 1 ? p.in[14] : (l == 2 ? p.in[22] : p.in[29])); const float* ab = l == 0 ? p.in[6] : (l == 1 ? p.in[15] : (l == 2 ? p.in[23] : p.in[30]));
        float acc[9];
#pragma unroll
        for (int i = 0; i < 9; ++i) acc[i] = 0.f;
        for (int k0 = kp * 128; k0 < kp * 128 + 128; k0 += 16) {
            float w[16];
#pragma unroll
            for (int u = 0; u < 16; ++u) w[u] = aw[(size_t)(k0 + u) * 3072 + col];
#pragma unroll
            for (int u = 0; u < 16; ++u)
#pragma unroll
                for (int i = 0; i < 9; ++i) acc[i] += sc[i * 1024 + k0 + u] * w[u]; }
#pragma unroll
        for (int i = 0; i < 9; ++i) red[(kp * 9 + i) * 64 + cl] = acc[i];
        __syncthreads();
        for (int o = tid; o < 9 * 64; o += 512) { const int i = o >> 6, c = o & 63; float s = 0.f; for (int q = 0; q < 8; ++q) s += red[(q * 9 + i) * 64 + c];
            ada[(size_t)(l * 9 + i) * 3072 + cb * 64 + c] = s + ab[cb * 64 + c]; }
        __syncthreads();
    }
}

DI void transpose_tile(const float* src, int ldsrc, int r0, int c0, bf16_t* dst, int lddst, lds_t lds) {
    LAS float* t = (LAS float*)lds;
    const int tid = otid(), rr = tid >> 3, cs = (tid & 7) * 8;
    const f32x4 a = *(const f32x4*)(src + (size_t)(r0 + rr) * ldsrc + c0 + cs), b = *(const f32x4*)(src + (size_t)(r0 + rr) * ldsrc + c0 + cs + 4);
#pragma unroll
    for (int e = 0; e < 4; ++e) { t[rr * 65 + cs + e] = a[e]; t[rr * 65 + cs + 4 + e] = b[e]; }
    __syncthreads();
    const int c = tid >> 3, rs = (tid & 7) * 8;
    u32x4 w; w.x = pack2(t[(rs + 0) * 65 + c], t[(rs + 1) * 65 + c]); w.y = pack2(t[(rs + 2) * 65 + c], t[(rs + 3) * 65 + c]);
    w.z = pack2(t[(rs + 4) * 65 + c], t[(rs + 5) * 65 + c]); w.w = pack2(t[(rs + 6) * 65 + c], t[(rs + 7) * 65 + c]);
    *(u32x4*)(dst + (size_t)(c0 + c) * lddst + r0 + rs) = w;
    __syncthreads();
}

template <int NG, int STATS>
DI void p1_rows(const PP& pin, lds_t lds, int l, bf16_t* U, const float* inw, int ldin, int goff, const float* gate_b) {
    const PP p = launder(pin);
    const int tid = otid(), wid = tid >> 6, lane = tid & 63;
    LAS float* wT = (LAS float*)lds;
    if (NG > 0) {
        constexpr int NIT = (NG > 0 ? NG : 4) / 2;
        f32x4 wv[NIT];
#pragma unroll
        for (int it = 0; it < NIT; ++it) { const int idx = tid + 512 * it, k = idx / (NG / 4), n4 = (idx % (NG / 4)) * 4; wv[it] = *(const f32x4*)(inw + (size_t)k * ldin + goff + n4); }
#pragma unroll
        for (int it = 0; it < NIT; ++it) { const int idx = tid + 512 * it, k = idx / (NG / 4), n4 = (idx % (NG / 4)) * 4;
            wT[(n4 + 0) * 1024 + k] = wv[it][0]; wT[(n4 + 1) * 1024 + k] = wv[it][1]; wT[(n4 + 2) * 1024 + k] = wv[it][2]; wT[(n4 + 3) * 1024 + k] = wv[it][3]; }
        __syncthreads();
    }
    const float* nw = tin(p, lbase(l)); const float* ada = (const float*)(p.ws + OFF_ADA) + (size_t)l * 9 * 3072;
    float* gates = (float*)(p.ws + OFF_GATES);
    f32x4 nw4[4];
#pragma unroll
    for (int i = 0; i < 4; ++i) nw4[i] = *(const f32x4*)(nw + lane * 4 + 256 * i);
    auto proc = [&](int row, f32x4 (&x)[4], const f32x4 (&shv)[4], const f32x4 (&scv)[4]) {
        const int b = row / LTOK, t = row - b * LTOK;
        float ss = 0.f;
#pragma unroll
        for (int i = 0; i < 4; ++i) ss += x[i][0] * x[i][0] + x[i][1] * x[i][1] + x[i][2] * x[i][2] + x[i][3] * x[i][3];
        ss = wsum(ss, lane); const float rstd = rsqrtf(ss * (1.f / 1024.f) + 1e-6f);
#pragma unroll
        for (int i = 0; i < 4; ++i) { const f32x4 sh = shv[i], scl = scv[i];
            x[i] = x[i] * rstd * nw4[i] * (scl + 1.f) + sh;
            u32x2 w; w.x = pack2(x[i][0], x[i][1]); w.y = pack2(x[i][2], x[i][3]);
            *(u32x2*)(U + (size_t)row * 1024 + lane * 4 + 256 * i) = w; }
        if (STATS) {
            const bf16_t* Og = (const bf16_t*)(p.ws + OFF_RO); const bf16_t* OCB = (const bf16_t*)(p.ws + OFF_OCB); f32x2* stg = (f32x2*)(p.ws + OFF_STATS);
            u32x4 ov[4];
#pragma unroll
            for (int hh = 0; hh < 4; ++hh) ov[hh] = *(const u32x4*)(Og + (size_t)row * 2048 + hh * 512 + lane * 8);
            f32x2 mine = {0.f, 1.f};
#pragma unroll
            for (int hh = 0; hh < 4; ++hh) {
                const int col = hh * 512 + lane * 8;
                float o[8] = {lo_f(ov[hh].x), hi_f(ov[hh].x), lo_f(ov[hh].y), hi_f(ov[hh].y), lo_f(ov[hh].z), hi_f(ov[hh].z), lo_f(ov[hh].w), hi_f(ov[hh].w)};
                if (t < 256) { const u32x4 cv = *(const u32x4*)(OCB + (size_t)(b * 256 + t) * 2048 + col);
                    o[0] += lo_f(cv.x); o[1] += hi_f(cv.x); o[2] += lo_f(cv.y); o[3] += hi_f(cv.y); o[4] += lo_f(cv.z); o[5] += hi_f(cv.z); o[6] += lo_f(cv.w); o[7] += hi_f(cv.w); }
                float mean = 0.f;
                if (STATS == 1) { float sm = 0.f;
#pragma unroll
                    for (int e = 0; e < 8; ++e) sm += o[e];
                    mean = wsum(sm, lane) * (1.f / 512.f); }
                float qq = 0.f;
#pragma unroll
                for (int e = 0; e < 8; ++e) { const float dlt = o[e] - mean; qq += dlt * dlt; }
                const float rs_ = rsqrtf(wsum(qq, lane) * (1.f / 512.f) + 1e-6f);
                if (lane == hh) mine = (f32x2){mean, rs_};
            }
            if (lane < 4) stg[(size_t)row * 4 + lane] = mine;
        }
    };
    auto gates2 = [&](int rowa, const f32x4 (&xa)[4], int rowb, const f32x4 (&xb)[4], bool hb) {
        float va[NG > 0 ? NG : 1], vb[NG > 0 ? NG : 1];
#pragma unroll
        for (int n = 0; n < NG; ++n) { float sa_ = 0.f, sb_ = 0.f;
#pragma unroll
            for (int i = 0; i < 4; ++i) { const f32x4 w = *(const LAS f32x4*)(wT + n * 1024 + lane * 4 + 256 * i);
                sa_ += xa[i][0] * w[0] + xa[i][1] * w[1] + xa[i][2] * w[2] + xa[i][3] * w[3];
                sb_ += xb[i][0] * w[0] + xb[i][1] * w[1] + xb[i][2] * w[2] + xb[i][3] * w[3]; }
            va[n] = sa_; vb[n] = sb_; }
#pragma unroll
        for (int k = 0; k < 6; ++k) { const int m = 32 >> k; const int hf = NG >> (k + 1);
            if (hf >= 1) { const bool up = (lane & m) != 0;
#pragma unroll
                for (int i = 0; i < hf; ++i) { const float ka = up ? va[hf + i] : va[i], sa2 = up ? va[i] : va[hf + i]; va[i] = ka + shx(sa2, m, lane);
                                               const float kb = up ? vb[hf + i] : vb[i], sb2 = up ? vb[i] : vb[hf + i]; vb[i] = kb + shx(sb2, m, lane); } }
            else { va[0] += shx(va[0], m, lane); vb[0] += shx(vb[0], m, lane); }
        }
        const int sh_ = NG == 32 ? 1 : 2, n = lane >> sh_;
        if ((lane & ((1 << sh_) - 1)) == 0) { const float gb = gate_b ? gate_b[n] : 0.f; gates[(size_t)rowa * 32 + n] = va[0] + gb; if (hb) gates[(size_t)rowb * 32 + n] = vb[0] + gb; }
    };
    const int stride = gridDim.x * 8;
    for (int rowa = blockIdx.x * 8 + wid; rowa < MTOK; rowa += 2 * stride) {
        const int rowb = rowa + stride; const bool hb = rowb < MTOK;
        const float* hpa = hrow(p, rowa, l); const float* hpb = hrow(p, hb ? rowb : rowa, l);
        f32x4 xa[4], xb[4], sha[4], sca[4], shb[4], scb[4];
        const int rb_ = hb ? rowb : rowa;
        const int ba_ = rowa / LTOK, ta_ = rowa - ba_ * LTOK, bb_ = rb_ / LTOK, tb_ = rb_ - bb_ * LTOK;
        const float* ada_a = ada + (ta_ < 256 ? 8 : ba_) * 3072; const float* ada_b = ada + (tb_ < 256 ? 8 : bb_) * 3072;
#pragma unroll
        for (int i = 0; i < 4; ++i) { xa[i] = *(const f32x4*)(hpa + lane * 4 + 256 * i); xb[i] = *(const f32x4*)(hpb + lane * 4 + 256 * i);
            sha[i] = *(const f32x4*)(ada_a + lane * 4 + 256 * i); sca[i] = *(const f32x4*)(ada_a + 1024 + lane * 4 + 256 * i);
            shb[i] = *(const f32x4*)(ada_b + lane * 4 + 256 * i); scb[i] = *(const f32x4*)(ada_b + 1024 + lane * 4 + 256 * i); }
        proc(rowa, xa, sha, sca);
        proc(rb_, xb, shb, scb);
        if (NG > 0) gates2(rowa, xa, rowb, xb, hb);
    }
}

DI void weights_prep(const Params& pin, lds_t lds, int l, int first) {
    const PP p = launder(pin);
    const int kind = lkind(l), lb = lbase(l);
    const float* inw = tin(p, lb + 3);
    const int ldin = kind == 0 ? 6160 : (kind == 1 ? 5152 : 6144), nmain = kind == 1 ? 5120 : 6144;
    bf16_t* WT = (bf16_t*)(p.ws + off_wt(l)); bf16_t* WO = (bf16_t*)(p.ws + off_wo(l));
    const float* ow = tin(p, lb + (kind == 0 ? 8 : (kind == 1 ? 7 : 6)));
    const int nt_in = 16 * (nmain / 64), nt_all = nt_in + 32 * 16;
    const int nw = (int)gridDim.x - first;
    if ((int)blockIdx.x < first || nw <= 0) return;
    for (int it = (int)blockIdx.x - first; it < nt_all; it += nw) {
        if (it < nt_in) { const int rt = it % 16, ct = it / 16; transpose_tile(inw, ldin, rt * 64, ct * 64, WT, 1024, lds); }
        else { const int j = it - nt_in, rt = j % 32, ct = j / 32; transpose_tile(ow, 1024, rt * 64, ct * 64, WO, 2048, lds); }
    }
}

DI void phase_p1(const Params& pin, lds_t lds, int l, bool full) {
    const PP p = launder(pin);
    const int kind = lkind(l), lb = lbase(l);
    const float* inw = tin(p, lb + 3);
    const int ldin = kind == 0 ? 6160 : (kind == 1 ? 5152 : 6144), nmain = kind == 1 ? 5120 : 6144;
    if (full) {
        if (l == 0) weights_prep(pin, lds, 0, 0);
        bf16_t* U = (bf16_t*)(p.ws + OFF_RQ);
        if (kind == 0) p1_rows<16, 0>(p, lds, l, U, inw, ldin, 6144, tin(p, lb + 6));
        else if (kind == 1) p1_rows<32, 0>(p, lds, l, U, inw, ldin, 5120, nullptr);
        else p1_rows<0, 0>(p, lds, l, U, inw, ldin, 0, nullptr);
    } else {
#ifdef FUSE_GATE
        if (kind == 1) p1_rows<0, 2>(p, lds, l, (bf16_t*)(p.ws + OFF_RQ), inw, ldin, 0, nullptr);
        else p1_rows<0, 1>(p, lds, l, (bf16_t*)(p.ws + OFF_RQ), inw, ldin, 0, nullptr);
#else
        p1_rows<0, 0>(p, lds, l, (bf16_t*)(p.ws + OFF_RQ), inw, ldin, 0, nullptr);
#endif
    }
}

DI int chunk_of(int dir, int s) { return dir == 0 ? s : (s < 4 ? 3 - s : 71 - s); }

DI void mlstm_chain(const Params& pin, lds_t lds, int b, int h) {
    const PP p = launder(pin);
    const int tid = otid(), wid = tid >> 6, lane = tid & 63;
    LAS float* btok = (LAS float*)lds;
    LAS float* ctok = btok + 2 * LTOK;
    LAS float* ptok = ctok + 2 * LTOK;
    LAS float* Bc = ptok + 2 * LTOK;
    LAS float* PMc = Bc + 136;
    LAS float* Mst = PMc + 136;
    const float* gates = (const float*)(p.ws + OFF_GATES);
    for (int q = wid; q < 136; q += 8) {
        const int dir = q / 68, c = q % 68;
        const int tk = c * 64 + (dir ? 63 - lane : lane);
        const float* gr = gates + (size_t)(b * LTOK + tk) * 32 + dir * 8 + h;
        const float gi = gr[0], lf = logsig(gr[4]);
        float bc = lf;
#pragma unroll
        for (int o = 1; o < 64; o <<= 1) { const float t = shup(bc, o, lane); if (lane >= o) bc += t; }
        const float cc = gi - bc; float pm = cc;
#pragma unroll
        for (int o = 1; o < 64; o <<= 1) { const float t = shup(pm, o, lane); if (lane >= o) pm = fmaxf(pm, t); }
        btok[dir * LTOK + tk] = bc; ctok[dir * LTOK + tk] = cc; ptok[dir * LTOK + tk] = pm;
        if (lane == 63) { Bc[q] = bc; PMc[q] = pm; }
    }
    __syncthreads();
    if (tid < 2) { float m = 0.f; for (int s = 0; s < 68; ++s) { const int c = chunk_of(tid, s); Mst[tid * 68 + c] = m; m = Bc[tid * 68 + c] + fmaxf(m, PMc[tid * 68 + c]); } }
    __syncthreads();
    float* SA = (float*)(p.ws + OFF_SA); float* SC = (float*)(p.ws + OFF_SC); float* SR = (float*)(p.ws + OFF_SR);
    float* SF = (float*)(p.ws + OFF_SF); float* SK = (float*)(p.ws + OFF_SK); float* DECS = (float*)(p.ws + OFF_DECS);
    for (int idx = tid; idx < 2 * LTOK; idx += 512) {
        const int dir = idx / LTOK, tk = idx - dir * LTOK, c = tk >> 6;
        const float mst = Mst[dir * 68 + c], pm = ptok[idx], cc = ctok[idx], bb = btok[idx];
        const float mx = fmaxf(mst, pm), mxe = fmaxf(mst, PMc[dir * 68 + c]);
        const size_t si = (size_t)((dir * 8 + b) * 4 + h) * LTOK + tk;
        SA[si] = -mx; SC[si] = cc; SR[si] = __expf(mst - mx); SF[si] = __expf(-mx - bb); SK[si] = __expf(cc - mxe);
    }
    if (tid < 136) { const int dir = tid / 68, c = tid % 68; const float mst = Mst[tid]; DECS[((dir * 8 + b) * 4 + h) * 68 + c] = __expf(mst - fmaxf(mst, PMc[tid])); }
    __syncthreads();
}

template <int DK, int kind>
DI void phase_p3(const Params& pin, lds_t lds, int l) {
    const PP p = launder(pin);
    constexpr int QSTR = DK * 2 + 16;
    const int tid = otid(), wid = tid >> 6, lane = tid & 63, fr = lane & 15, fq = lane >> 4;
    lds_t Qt = lds, Kt = lds + 64 * QSTR, Kh = lds + 128 * QSTR;
    LAS float* misc = (LAS float*)(lds + 192 * QSTR);
    LAS float* fA = misc; LAS float* fC = misc + 128; LAS float* rsl = misc + 256;
    LAS float* code = misc + 512;
    LAS float* Bc = misc + 512 + 1024;
    LAS float* tot = Bc + 64 * 128;
    const bf16_t* QK = (const bf16_t*)(p.ws + OFF_RO);
    bf16_t* Qs = (bf16_t*)(p.ws + OFF_RQ); bf16_t* KTg = (bf16_t*)(p.ws + OFF_RK); bf16_t* Sg = (bf16_t*)(p.ws + OFF_RS);
    float* SA = (float*)(p.ws + OFF_SA); float* SC = (float*)(p.ws + OFF_SC); float* SR = (float*)(p.ws + OFF_SR);
    float* SK = (float*)(p.ws + OFF_SK); float* RSUM = (float*)(p.ws + OFF_RSUM); float* DECS = (float*)(p.ws + OFF_DECS); float* DEC = (float*)(p.ws + OFF_DEC);
    const int lb = lbase(l);
    for (int it = blockIdx.x; it < 8 * 68 * 4; it += gridDim.x) {
        const int h = it & 3, c = (it >> 2) % 68, b = it / (4 * 68);
        const int row0 = b * LTOK + c * 64;
        const int npass = (kind == 1) ? 2 : 1;
        for (int pass = 0; pass < npass; ++pass) {
            if (kind == 0) {
                const float* cw = tin(p, lb + 4); const float* cbias = tin(p, lb + 5);
                if (tid < 128) { const int dir = tid >> 6, jj = tid & 63; const size_t si = (size_t)((dir * 8 + b) * 4 + h) * LTOK + c * 64 + jj; fA[tid] = SA[si]; fC[tid] = SC[si]; }
                const int pc = tid & 63, x0 = (tid >> 6) * 8, which = pc >> 5, cc0 = (pc & 31) * 8, col = which * 1024 + h * 256 + cc0;
                float acc[8][8];
                { const f32x4 b0 = *(const f32x4*)(cbias + col), b1 = *(const f32x4*)(cbias + col + 4);
#pragma unroll
                  for (int xo = 0; xo < 8; ++xo)
#pragma unroll
                      for (int e = 0; e < 4; ++e) { acc[xo][e] = b0[e]; acc[xo][4 + e] = b1[e]; } }
#pragma unroll
                for (int dy = 0; dy < 3; ++dy) {
                    const int yy = c - 4 + dy - 1;
                    const bool rowok = c >= 4 ? (yy >= 0 && yy < 64) : (dy == 1);
                    if (rowok) {
                        float w[3][8];
#pragma unroll
                        for (int dx = 0; dx < 3; ++dx) { const f32x4 w0 = *(const f32x4*)(cw + (dy * 3 + dx) * 2048 + col), w1 = *(const f32x4*)(cw + (dy * 3 + dx) * 2048 + col + 4);
#pragma unroll
                            for (int e = 0; e < 4; ++e) { w[dx][e] = w0[e]; w[dx][4 + e] = w1[e]; } }
                        const int rbase = c >= 4 ? (b * LTOK + 256 + yy * 64) : (b * LTOK + c * 64);
                        const int lo = c >= 4 ? 0 : -(c * 64), hi = c >= 4 ? 64 : 256 - c * 64;
#pragma unroll
                        for (int xi = -1; xi <= 8; ++xi) {
                            const int x = x0 + xi;
                            u32x4 v = {0u, 0u, 0u, 0u};
                            if (x >= lo && x < hi) v = *(const u32x4*)(QK + (size_t)(rbase + x) * 2048 + col);
                            const float f[8] = {lo_f(v.x), hi_f(v.x), lo_f(v.y), hi_f(v.y), lo_f(v.z), hi_f(v.z), lo_f(v.w), hi_f(v.w)};
#pragma unroll
                            for (int dx = 0; dx < 3; ++dx) { const int xo = xi + 1 - dx;
                                if (xo >= 0 && xo < 8) {
#pragma unroll
                                    for (int e = 0; e < 8; ++e) acc[xo][e] += f[e] * w[dx][e]; } }
                        }
                    }
                }
                const float sc = which ? 0.0625f : 1.f;
#pragma unroll
                for (int xo = 0; xo < 8; ++xo) {
                    float y[8];
#pragma unroll
                    for (int e = 0; e < 8; ++e) y[e] = siluf(acc[xo][e]) * sc;
                    u32x4 w; w.x = pack2(y[0], y[1]); w.y = pack2(y[2], y[3]); w.z = pack2(y[4], y[5]); w.w = pack2(y[6], y[7]);
                    *(LAS u32x4*)((which ? Kt : Qt) + (x0 + xo) * QSTR + cc0 * 2) = w;
                }
            } else if (kind == 2) {
                const float* dl = tin(p, lb + 4);
                if (tid < 128) { const int dir = tid >> 6, jj = tid & 63; const float lg = logsig(dl[dir * 4 + h]); const float fj = (float)jj;
                    fA[tid] = dir == 0 ? fj * lg : -fj * lg; fC[tid] = dir == 0 ? -fj * lg : fj * lg;
                    const size_t si = (size_t)((dir * 8 + b) * 4 + h) * LTOK + c * 64 + jj;
                    SR[si] = dir == 0 ? __expf((fj + 1.f) * lg) : __expf((64.f - fj) * lg);
                    SK[si] = dir == 0 ? __expf((63.f - fj) * lg) : __expf(fj * lg);
                    if (jj == 0) DECS[((dir * 8 + b) * 4 + h) * 68 + c] = __expf(64.f * lg); }
                const int j = tid >> 3, g = tid & 7;
#pragma unroll
                for (int half = 0; half < 2; ++half) {
                    const float pos = half == 0 ? (float)(c - 4) : (float)j;
                    float cs[8], sn[8];
#pragma unroll
                    for (int e = 0; e < 8; ++e) { const int i = g * 8 + e; const float f = exp2f(-(float)i * (13.287712379549449f / 64.f));
                        float rev = pos * f * 0.15915494309189535f; rev -= rintf(rev);
                        cs[e] = c >= 4 ? __builtin_amdgcn_cosf(rev) : 1.f; sn[e] = c >= 4 ? __builtin_amdgcn_sinf(rev) : 0.f; }
#pragma unroll
                    for (int which = 0; which < 2; ++which) {
                        const int col = which * 1024 + h * 256 + half * 128 + g * 8;
                        const u32x4 v1 = *(const u32x4*)(QK + (size_t)(row0 + j) * 2048 + col), v2 = *(const u32x4*)(QK + (size_t)(row0 + j) * 2048 + col + 64);
                        float x1[8] = {lo_f(v1.x), hi_f(v1.x), lo_f(v1.y), hi_f(v1.y), lo_f(v1.z), hi_f(v1.z), lo_f(v1.w), hi_f(v1.w)};
                        float x2[8] = {lo_f(v2.x), hi_f(v2.x), lo_f(v2.y), hi_f(v2.y), lo_f(v2.z), hi_f(v2.z), lo_f(v2.w), hi_f(v2.w)};
                        float o1[8], o2[8]; const float sc = which ? 0.0625f : 1.f;
#pragma unroll
                        for (int e = 0; e < 8; ++e) { o1[e] = (x1[e] * cs[e] - x2[e] * sn[e]) * sc; o2[e] = (x1[e] * sn[e] + x2[e] * cs[e]) * sc; }
                        u32x4 w1, w2; w1.x = pack2(o1[0], o1[1]); w1.y = pack2(o1[2], o1[3]); w1.z = pack2(o1[4], o1[5]); w1.w = pack2(o1[6], o1[7]);
                        w2.x = pack2(o2[0], o2[1]); w2.y = pack2(o2[2], o2[3]); w2.z = pack2(o2[4], o2[5]); w2.w = pack2(o2[6], o2[7]);
                        lds_t dst = (which ? Kt : Qt) + j * QSTR + (half * 128 + g * 8) * 2;
                        *(LAS u32x4*)dst = w1; *(LAS u32x4*)(dst + 128) = w2;
                    }
                }
            } else {
                const int dir = pass;
                const float* gates = (const float*)(p.ws + OFF_GATES);
                const float* w2 = tin(p, lb + 4) + (size_t)dir * 16 * 512; const float* gb = tin(p, lb + 5) + dir * 512;
                const int d = tid & 127, g = tid >> 7;
                float wr_[16];
#pragma unroll
                for (int r = 0; r < 16; ++r) wr_[r] = w2[r * 512 + h * 128 + d];
                const float bias = gb[h * 128 + d];
                bf16_t qraw[16], kraw[16];
#pragma unroll
                for (int q = 0; q < 16; ++q) { const int pp = g * 16 + q, ll = dir ? 63 - pp : pp;
                    qraw[q] = QK[(size_t)(row0 + ll) * 1024 + h * 128 + d]; kraw[q] = QK[(size_t)(row0 + ll) * 1024 + 512 + h * 128 + d]; }
                for (int idx = tid; idx < 1024; idx += 512) { const int ll = idx >> 4, r = idx & 15; code[idx] = gates[(size_t)(row0 + ll) * 32 + dir * 16 + r]; }
                if (tid < 128) { fA[tid] = 0.f; fC[tid] = 0.f; }
                __syncthreads();
                float run = 0.f;
                for (int q = 0; q < 16; ++q) { const int pp = g * 16 + q, ll = dir ? 63 - pp : pp; float pre = bias;
#pragma unroll
                    for (int r = 0; r < 16; ++r) pre += code[ll * 16 + r] * wr_[r];
                    run += logsig(pre) * (1.f / 16.f); Bc[pp * 128 + d] = run; }
                tot[g * 128 + d] = run;
                __syncthreads();
                float off = 0.f, bend = 0.f;
#pragma unroll
                for (int gg = 0; gg < 4; ++gg) { const float t = tot[gg * 128 + d]; if (gg < g) off += t; bend += t; }
#pragma unroll
                for (int q = 0; q < 16; ++q) { const int pp = g * 16 + q, ll = dir ? 63 - pp : pp; const float bf = Bc[pp * 128 + d] + off;
                    const float qv = bf2f(qraw[q]), kv = bf2f(kraw[q]);
                    *(LAS bf16_t*)(Qt + ll * QSTR + d * 2) = f2bf(qv * 0.08838834764831845f * __expf(bf));
                    *(LAS bf16_t*)(Kt + ll * QSTR + d * 2) = f2bf(kv * __expf(-bf));
                    *(LAS bf16_t*)(Kh + ll * QSTR + d * 2) = f2bf(kv * __expf(bend - bf)); }
                if (g == 0) DEC[(size_t)(((dir * 8 + b) * 4 + h) * 68 + c) * 128 + d] = __expf(bend);
            }
            __syncthreads();
            {
                const int rb = wid & 3, cbp = wid >> 2;
                f32x4 a0 = {0.f, 0.f, 0.f, 0.f}, a1 = {0.f, 0.f, 0.f, 0.f};
#pragma unroll
                for (int kk = 0; kk < DK / 32; ++kk) {
                    const bf16x8 A = *(const LAS bf16x8*)(Qt + (16 * rb + fr) * QSTR + kk * 64 + fq * 16);
                    const bf16x8 B0 = *(const LAS bf16x8*)(Kt + (32 * cbp + fr) * QSTR + kk * 64 + fq * 16);
                    const bf16x8 B1 = *(const LAS bf16x8*)(Kt + (32 * cbp + 16 + fr) * QSTR + kk * 64 + fq * 16);
                    a0 = MFMA16(A, B0, a0); a1 = MFMA16(A, B1, a1);
                }
                for (int dd = (kind == 1 ? pass : 0); dd < (kind == 1 ? pass + 1 : 2); ++dd) {
                    bf16_t* St = Sg + (size_t)(((dd * 8 + b) * 4 + h) * 68 + c) * 4096;
                    float rs[4] = {0.f, 0.f, 0.f, 0.f};
#pragma unroll
                    for (int t = 0; t < 2; ++t) { const int ll = 32 * cbp + 16 * t + fr; const float cl = fC[dd * 64 + ll];
#pragma unroll
                        for (int i = 0; i < 4; ++i) { const int j = 16 * rb + 4 * fq + i; const bool ok = dd == 0 ? (ll <= j) : (ll >= j);
                            const float a = t == 0 ? a0[i] : a1[i];
                            const float v = ok ? (kind == 1 ? a : a * __expf(fA[dd * 64 + j] + cl)) : 0.f;
                            const bf16_t hb = f2bf(v); St[j * 64 + ll] = hb; rs[i] += bf2f(hb); } }
                    if (kind == 0) {
#pragma unroll
                        for (int i = 0; i < 4; ++i) { float s = rs[i]; s = DPP_ADD(s, 0xB1); s = DPP_ADD(s, 0x4E); s = DPP_ADD(s, 0x141); s = DPP_ADD(s, 0x140);
                            if (fr == 0) rsl[(dd * 2 + cbp) * 64 + 16 * rb + 4 * fq + i] = s; }
                    }
                }
            }
            if (kind != 1) {
#pragma unroll
                for (int i = 0; i < 4; ++i) { const int pi = tid + 512 * i, j = pi >> 5, d8 = pi & 31;
                    *(u32x4*)(Qs + (size_t)(row0 + j) * 1024 + h * 256 + d8 * 8) = *(const LAS u32x4*)(Qt + j * QSTR + d8 * 16); }
            } else {
#pragma unroll
                for (int i = 0; i < 2; ++i) { const int pi = tid + 512 * i, j = pi >> 4, d8 = pi & 15;
                    *(u32x4*)(Qs + (size_t)pass * MTOK * 512 + (size_t)(row0 + j) * 512 + h * 128 + d8 * 8) = *(const LAS u32x4*)(Qt + j * QSTR + d8 * 16); }
            }
            {
                lds_t Ksrc = kind == 1 ? Kh : Kt;
                bf16_t* KTt = KTg + (size_t)((kind == 1 ? ((pass * 8 + b) * 4 + h) : (b * 4 + h)) * 68 + c) * (DK * 64);
#pragma unroll
                for (int i = 0; i < DK / 64; ++i) { const int pi = tid + 512 * i, d = pi >> 3, l8 = pi & 7;
                    unsigned x[8];
#pragma unroll
                    for (int e = 0; e < 8; ++e) x[e] = *(const LAS bf16_t*)(Ksrc + (l8 * 8 + e) * QSTR + d * 2);
                    u32x4 w; w.x = x[0] | (x[1] << 16); w.y = x[2] | (x[3] << 16); w.z = x[4] | (x[5] << 16); w.w = x[6] | (x[7] << 16);
                    *(u32x4*)(KTt + d * 64 + l8 * 8) = w; }
            }
            __syncthreads();
            if (kind == 0 && tid < 128) { const int dir = tid >> 6, jj = tid & 63;
                RSUM[(size_t)((dir * 8 + b) * 4 + h) * LTOK + c * 64 + jj] = rsl[(dir * 2) * 64 + jj] + rsl[(dir * 2 + 1) * 64 + jj]; }
        }
    }
}

template <int DK>
struct ScanState { f32x4 st[DK / 16]; float nreg; };

template <int DK>
DI void scan_steps(const Params& pin, lds_t lds, int kind, int item, int s_lo, int s_hi, ScanState<DK>& S) {
    const PP p = launder(pin);
    constexpr int QSTR = DK * 2 + 16, NT = DK / 16;
    const int tid = otid(), wid = tid >> 6, lane = tid & 63, fr = lane & 15, fq = lane >> 4;
    const int xcd = item & 7, slot = item >> 3, bh = xcd * 4 + (slot >> 3), sub = slot & 7, dir = sub >> 2, vs = sub & 3, b = bh >> 2, h = bh & 3;
    lds_t Ql = lds, KTl = lds + 64 * QSTR, VTl = KTl + DK * 144, Sl = VTl + 128 * 144;
    LAS float* misc = (LAS float*)(Sl + 64 * 144);
    LAS float* rl = misc; LAS float* rsl = misc + 64; LAS float* fll = misc + 128; LAS float* qnl = misc + 192; LAS float* decl = misc + 256;
    LAS float* nl = misc + 384;
    LAS float* rrl = misc + 896;
    const bf16_t* Qg = (const bf16_t*)(p.ws + OFF_RQ) + (kind == 1 ? (size_t)dir * MTOK * 512 : 0);
    const int ldq = kind == 1 ? 512 : 1024;
    const bf16_t* KTg = (const bf16_t*)(p.ws + OFF_RK); const bf16_t* VT = (const bf16_t*)(p.ws + OFF_R0); const bf16_t* Sg = (const bf16_t*)(p.ws + OFF_RS);
    const float* SR = (const float*)(p.ws + OFF_SR); const float* SF = (const float*)(p.ws + OFF_SF); const float* SK = (const float*)(p.ws + OFF_SK);
    const float* RSUM = (const float*)(p.ws + OFF_RSUM); const float* DECS = (const float*)(p.ws + OFF_DECS); const float* DEC = (const float*)(p.ws + OFF_DEC);
    bf16_t* Og = (bf16_t*)(p.ws + OFF_RO); bf16_t* OCB = (bf16_t*)(p.ws + OFF_OCB);
    const int dbh = (dir * 8 + b) * 4 + h;
    u32x4 pq[DK / 64], pk[DK / 64], pv[2], ps; float pks = 1.f;
    float pr = 1.f, prs = 0.f, pfl = 1.f, pdec = 1.f, pdsc = 1.f;
    const int l8 = tid & 7;
    unsigned voffZ = 0u; asm volatile("" : "+v"(voffZ));
    const int aoff = swz16x32(fr * 64 + fq * 16);
    const unsigned voffO = (unsigned)(fr * 2048 + 16 * wid + 4 * fq) * 2u;
    const unsigned voffF = (unsigned)tid * 4u, voffR = (unsigned)(tid / (DK / 8)) * 4u;
    const unsigned voffQ = (unsigned)((tid / (DK / 8)) * ldq + (tid % (DK / 8)) * 8) * 2u, voffT = (unsigned)tid * 16u, voffV = (unsigned)((tid >> 3) * MTOK + l8 * 8) * 2u;
    const __amdgpu_buffer_rsrc_t rs_ws = __builtin_amdgcn_make_buffer_rsrc((void*)p.ws, (short)0, (int)WS_END, 0x00020000);
    const unsigned qdir_ = (unsigned)OFF_RQ + (kind == 1 ? (unsigned)dir * (unsigned)(MTOK * 512 * 2) : 0u);
#define SCAN_ISSUE(sn) do { \
        const int c_ = chunk_of(dir, (sn)), row0_ = b * LTOK + c_ * 64; const unsigned sidx4_ = (unsigned)(dbh * LTOK + c_ * 64) * 4u; \
        const unsigned qs_ = qdir_ + (unsigned)(row0_ * ldq + h * DK) * 2u; \
        _Pragma("unroll") for (int i = 0; i < DK / 64; ++i) pq[i] = __builtin_amdgcn_raw_buffer_load_b128(rs_ws, voffQ, qs_ + (unsigned)(i * (4096 / DK) * ldq * 2), 0); \
        const unsigned ks_ = (unsigned)OFF_RK + (unsigned)(((kind == 1 ? dbh : (b * 4 + h)) * 68 + c_) * (DK * 64)) * 2u; \
        _Pragma("unroll") for (int i = 0; i < DK / 64; ++i) pk[i] = __builtin_amdgcn_raw_buffer_load_b128(rs_ws, voffT, ks_ + (unsigned)(i * 8192), 0); \
        if (kind != 1 && tid < 64) pks = __builtin_bit_cast(float, __builtin_amdgcn_raw_buffer_load_b32(rs_ws, voffF, (unsigned)OFF_SK + sidx4_, 0)); \
        const unsigned vs_ = (unsigned)OFF_R0 + (unsigned)((h * 512 + vs * 128) * MTOK + row0_) * 2u; \
        _Pragma("unroll") for (int i = 0; i < 2; ++i) pv[i] = __builtin_amdgcn_raw_buffer_load_b128(rs_ws, voffV, vs_ + (unsigned)(i * 64 * MTOK * 2), 0); \
        ps = __builtin_amdgcn_raw_buffer_load_b128(rs_ws, voffT, (unsigned)OFF_RS + (unsigned)((dbh * 68 + c_) * 4096) * 2u, 0); \
        if (kind != 1 && tid < 64) pr = __builtin_bit_cast(float, __builtin_amdgcn_raw_buffer_load_b32(rs_ws, voffF, (unsigned)OFF_SR + sidx4_, 0)); \
        if (kind == 0 && tid < 64) { prs = __builtin_bit_cast(float, __builtin_amdgcn_raw_buffer_load_b32(rs_ws, voffF, (unsigned)OFF_RSUM + sidx4_, 0)); \
                                     pfl = __builtin_bit_cast(float, __builtin_amdgcn_raw_buffer_load_b32(rs_ws, voffF, (unsigned)OFF_SF + sidx4_, 0)); } \
        if (kind == 1 && tid < 128) pdec = __builtin_bit_cast(float, __builtin_amdgcn_raw_buffer_load_b32(rs_ws, voffF, (unsigned)OFF_DEC + (unsigned)((dbh * 68 + c_) * 128) * 4u, 0)); \
        if (kind != 1) pdsc = __builtin_bit_cast(float, __builtin_amdgcn_raw_buffer_load_b32(rs_ws, voffZ, (unsigned)OFF_DECS + (unsigned)(dbh * 68 + c_) * 4u, 0)); \
    } while (0)
    SCAN_ISSUE(s_lo);
    for (int s = s_lo; s < s_hi; ++s) {
        const int c = chunk_of(dir, s), row0 = b * LTOK + c * 64, par = s & 1;
        {
#pragma unroll
            for (int i = 0; i < DK / 64; ++i) { const int pi = tid + 512 * i, j = pi / (DK / 8), d8 = pi % (DK / 8);
                const int kk_ = d8 >> 2, u_ = d8 & 3, f_ = (u_ & 1) * 2, sub_ = u_ >> 1, rr_ = j & 15;
                lds_t qb_ = Ql + ((j >> 4) * (DK / 32) + kk_) * 1024 + sub_ * 8;
                *(LAS u32x2*)(qb_ + swz16x32(rr_ * 64 + f_ * 16)) = (u32x2){pq[i].x, pq[i].y};
                *(LAS u32x2*)(qb_ + swz16x32(rr_ * 64 + (f_ + 1) * 16)) = (u32x2){pq[i].z, pq[i].w}; }
            const int ks8_ = l8 >> 2, c8_ = l8 & 3;
#pragma unroll
            for (int i = 0; i < DK / 64; ++i) { const int pi = tid + 512 * i, d = pi >> 3;
                *(LAS u32x4*)(KTl + ((d >> 4) * 2 + ks8_) * 1024 + swz16x32((d & 15) * 64 + c8_ * 16)) = pk[i]; }
#pragma unroll
            for (int i = 0; i < 2; ++i) { const int pi = tid + 512 * i, vr = pi >> 3;
                *(LAS u32x4*)(VTl + ((vr >> 4) * 2 + ks8_) * 1024 + swz16x32((vr & 15) * 64 + c8_ * 16)) = pv[i]; }
            { const int j = tid >> 3; *(LAS u32x4*)(Sl + ((j >> 4) * 2 + ks8_) * 1024 + swz16x32((j & 15) * 64 + c8_ * 16)) = ps; }
            if (kind == 0 && tid < 64) { rsl[tid] = prs; fll[tid] = pfl; }
            if (kind != 1 && tid < 64) { rl[tid] = pks; rrl[tid] = pr; }
            if (kind == 0 && tid < 64) ((LAS bf16_t*)decl)[tid] = f2bf(pks);
            if (kind == 1 && tid < 128) decl[tid] = pdec;
        }
        const float dsc = pdsc;
        __syncthreads();
        u32x2 oo[4];
        if (s >= 36) {
#pragma unroll
            for (int rb = 0; rb < 4; ++rb) oo[rb] = __builtin_amdgcn_raw_buffer_load_b64(rs_ws, voffO, (unsigned)OFF_RO + (unsigned)((row0 + 16 * rb) * 2048 + h * 512 + vs * 128) * 2u, 0); }
        if (s + 1 < s_hi) SCAN_ISSUE(s + 1);
        if (kind == 0) {
            LAS unsigned char* nlb = (LAS unsigned char*)nl;
            { const int j = tid >> 3, part = tid & 7; float a = 0.f;
#pragma unroll
              for (int q = 0; q < 4; ++q) { const u32x4 v = *(const LAS u32x4*)(Ql + ((j >> 4) * (DK / 32) + part) * 1024 + swz16x32((j & 15) * 64 + q * 16));
                  const u32x4 nn = *(const LAS u32x4*)(nlb + par * 512 + (part * 32 + q * 8) * 2);
                  a = dot2(v.x, nn.x, a); a = dot2(v.y, nn.y, a); a = dot2(v.z, nn.z, a); a = dot2(v.w, nn.w, a); }
              a = DPP_ADD(a, 0xB1); a = DPP_ADD(a, 0x4E); a = DPP_ADD(a, 0x141);
              if (part == 0) qnl[j] = a; }
            if (tid < DK) { float sum = 0.f;
#pragma unroll
                for (int q = 0; q < 8; ++q) { const u32x4 v = *(const LAS u32x4*)(KTl + ((tid >> 4) * 2 + (q >> 2)) * 1024 + swz16x32((tid & 15) * 64 + (q & 3) * 16));
                    const u32x4 kk = *(const LAS u32x4*)((LAS unsigned char*)decl + q * 16);
                    sum = dot2(v.x, kk.x, sum); sum = dot2(v.y, kk.y, sum); sum = dot2(v.z, kk.z, sum); sum = dot2(v.w, kk.w, sum); }
                const int x_ = tid & 31, px_ = x_ < 16 ? 8 * (x_ >> 2) + (x_ & 3) : 8 * ((x_ - 16) >> 2) + 4 + (x_ & 3);
                S.nreg = dsc * S.nreg + sum; *(LAS bf16_t*)(nlb + (par ^ 1) * 512 + ((tid & ~31) + px_) * 2) = f2bf(S.nreg); }
        }
        f32x4 ax[4];
#pragma unroll
        for (int rb = 0; rb < 4; ++rb) ax[rb] = (f32x4){0.f, 0.f, 0.f, 0.f};
        u32x4 fa[2][4];
#define SCAN_LOADQ(slot, kk_) do { _Pragma("unroll") for (int rb = 0; rb < 4; ++rb) \
            fa[slot][rb] = *(const LAS u32x4*)(Ql + aoff + (rb * (DK / 32) + (kk_)) * 1024); } while (0)
#define SCAN_LOADS(slot, ks_) do { _Pragma("unroll") for (int rb = 0; rb < 4; ++rb) \
            fa[slot][rb] = *(const LAS u32x4*)(Sl + aoff + (rb * 2 + (ks_)) * 1024); } while (0)
#define SCAN_LOADK(slot, tp_) do { _Pragma("unroll") for (int q_ = 0; q_ < 4; ++q_) \
            fa[slot][q_] = *(const LAS u32x4*)(KTl + aoff + ((2 * (tp_) + (q_ >> 1)) * 2 + (q_ & 1)) * 1024); } while (0)
        constexpr int NKK = DK / 32;
        SCAN_LOADQ(0, 0);
#pragma unroll
        for (int kk = 0; kk < NKK; ++kk) {
            if (kk + 1 < NKK) SCAN_LOADQ((kk + 1) & 1, kk + 1); else SCAN_LOADS((kk + 1) & 1, 0);
            __builtin_amdgcn_sched_barrier(0);
            u32x4 sw; sw.x = pack2(S.st[2 * kk][0], S.st[2 * kk][1]); sw.y = pack2(S.st[2 * kk][2], S.st[2 * kk][3]);
            sw.z = pack2(S.st[2 * kk + 1][0], S.st[2 * kk + 1][1]); sw.w = pack2(S.st[2 * kk + 1][2], S.st[2 * kk + 1][3]);
            const bf16x8 sf = __builtin_bit_cast(bf16x8, sw);
#pragma unroll
            for (int rb = 0; rb < 4; ++rb) ax[rb] = MFMA16(sf, __builtin_bit_cast(bf16x8, fa[kk & 1][rb]), ax[rb]);
            __builtin_amdgcn_sched_barrier(0);
        }
        bf16x8 bv[2];
#pragma unroll
        for (int ks = 0; ks < 2; ++ks) bv[ks] = *(const LAS bf16x8*)(VTl + aoff + (wid * 2 + ks) * 1024);
        SCAN_LOADS((NKK + 1) & 1, 1);
        float rj[4] = {1.f, 1.f, 1.f, 1.f};
        if (kind != 1) {
#pragma unroll
            for (int rb = 0; rb < 4; ++rb) rj[rb] = rrl[16 * rb + fr]; }
        __builtin_amdgcn_sched_barrier(0);
        if (kind != 1) {
#pragma unroll
            for (int rb = 0; rb < 4; ++rb) ax[rb] = ax[rb] * rj[rb]; }
#pragma unroll
        for (int rb = 0; rb < 4; ++rb) ax[rb] = MFMA16(bv[0], __builtin_bit_cast(bf16x8, fa[NKK & 1][rb]), ax[rb]);
        __builtin_amdgcn_sched_barrier(0);
        SCAN_LOADK(NKK & 1, 0);
        __builtin_amdgcn_sched_barrier(0);
#pragma unroll
        for (int rb = 0; rb < 4; ++rb) ax[rb] = MFMA16(bv[1], __builtin_bit_cast(bf16x8, fa[(NKK + 1) & 1][rb]), ax[rb]);
        __builtin_amdgcn_sched_barrier(0);
        if (kind == 0) __syncthreads();
        const bool to_cb = (dir == 1) && (s < 4);
#pragma unroll
        for (int rb = 0; rb < 4; ++rb) { const int j = 16 * rb + fr;
            f32x4 v = ax[rb];
            { if (kind == 0) { const float den = rsl[j] + rj[rb] * qnl[j]; const float inv = __builtin_amdgcn_rcpf(fmaxf(fabsf(den), fll[j])); v = v * inv; } }
            const unsigned dsto = (to_cb ? (unsigned)OFF_OCB + (unsigned)((b * 256 + c * 64 + 16 * rb) * 2048) * 2u : (unsigned)OFF_RO + (unsigned)((row0 + 16 * rb) * 2048) * 2u) + (unsigned)(h * 512 + vs * 128) * 2u;
            if (s >= 36) { const u32x2 o = oo[rb]; v[0] += lo_f(o.x); v[1] += hi_f(o.x); v[2] += lo_f(o.y); v[3] += hi_f(o.y); }
            u32x2 w; w.x = pack2(v[0], v[1]); w.y = pack2(v[2], v[3]); __builtin_amdgcn_raw_buffer_store_b64(w, rs_ws, voffO, dsto, 0); }
        bf16x8 bvs[2];
#pragma unroll
        for (int ks = 0; ks < 2; ++ks) {
            if (kind != 1) { const f32x4 c0 = *(const LAS f32x4*)(rl + 32 * ks + 8 * fq), c1 = *(const LAS f32x4*)(rl + 32 * ks + 8 * fq + 4);
                const u32x4 v = __builtin_bit_cast(u32x4, bv[ks]); u32x4 w;
                w.x = pack2(lo_f(v.x) * c0[0], hi_f(v.x) * c0[1]); w.y = pack2(lo_f(v.y) * c0[2], hi_f(v.y) * c0[3]);
                w.z = pack2(lo_f(v.z) * c1[0], hi_f(v.z) * c1[1]); w.w = pack2(lo_f(v.w) * c1[2], hi_f(v.w) * c1[3]);
                bvs[ks] = __builtin_bit_cast(bf16x8, w); }
            else bvs[ks] = bv[ks];
        }
        __builtin_amdgcn_sched_barrier(0);
        constexpr int NTP = NT / 2;
        f32x4 dd[2][2];
        if (kind == 1) { dd[NKK & 1][0] = *(const LAS f32x4*)(decl + 4 * fq); dd[NKK & 1][1] = *(const LAS f32x4*)(decl + 16 + 4 * fq); }
#pragma unroll
        for (int tp = 0; tp < NTP; ++tp) {
            const int cur = (NKK + tp) & 1;
            if (tp + 1 < NTP) { SCAN_LOADK(cur ^ 1, tp + 1);
                if (kind == 1) { dd[cur ^ 1][0] = *(const LAS f32x4*)(decl + 16 * (2 * tp + 2) + 4 * fq); dd[cur ^ 1][1] = *(const LAS f32x4*)(decl + 16 * (2 * tp + 3) + 4 * fq); } }
            __builtin_amdgcn_sched_barrier(0);
#pragma unroll
            for (int u = 0; u < 2; ++u) { const int t = 2 * tp + u;
                f32x4 d4 = {dsc, dsc, dsc, dsc};
                if (kind == 1) d4 = dd[cur][u];
                f32x4 stv = S.st[t] * d4;
                stv = MFMA16(__builtin_bit_cast(bf16x8, fa[cur][2 * u]), bvs[0], stv);
                stv = MFMA16(__builtin_bit_cast(bf16x8, fa[cur][2 * u + 1]), bvs[1], stv);
                S.st[t] = stv; }
            __builtin_amdgcn_sched_barrier(0);
        }
#undef SCAN_LOADQ
#undef SCAN_LOADS
#undef SCAN_LOADK
        __syncthreads();
    }
}

template <int DK>
DI void phase_scan(const Params& p, lds_t lds, int kind) {
    const int G = gridDim.x, nround = (256 + G - 1) / G;
    for (int rd = 0; rd < nround; ++rd) {
        const int item = rd * G + blockIdx.x; const bool valid = item < 256;
        ScanState<DK> S;
#pragma unroll
        for (int t = 0; t < DK / 16; ++t) S.st[t] = (f32x4){0.f, 0.f, 0.f, 0.f};
        S.nreg = 0.f;
        if (valid) {
            LAS float* nl = (LAS float*)(lds + 64 * (DK * 2 + 16) + DK * 144 + 128 * 144 + 64 * 144) + 384;
            nl[otid()] = 0.f;
            __syncthreads();
            scan_steps<DK>(p, lds, kind, item, 0, 36, S);
        }
        xcd_barrier(p, lds);
        if (valid) scan_steps<DK>(p, lds, kind, item, 36, 68, S);
    }
}

DI void phase_p5(const Params& pin, int l, bool dummy) {
    const PP p = launder(pin);
    const int kind = lkind(l), lb = lbase(l);
    const int tid = otid(), wid = tid >> 6, lane = tid & 63;
    const float* hw = tin(p, lb + (kind == 0 ? 7 : (kind == 1 ? 6 : 5)));
    bf16_t* Og = (bf16_t*)(p.ws + OFF_RO); const bf16_t* Z = (const bf16_t*)(p.ws + OFF_R0); const bf16_t* OCB = (const bf16_t*)(p.ws + OFF_OCB);
    bf16_t* Yg = dummy ? (bf16_t*)(p.ws + OFF_RQ) : Og;
    const bool center = kind != 1;
    f32x4 hwv[4][2];
#pragma unroll
    for (int h = 0; h < 4; ++h) { hwv[h][0] = *(const f32x4*)(hw + h * 512 + lane * 8); hwv[h][1] = *(const f32x4*)(hw + h * 512 + lane * 8 + 4); }
    auto proc = [&](int row, const u32x4 (&ovv)[4], const u32x4 (&zvv)[4]) {
        const int b = row / LTOK, t = row - b * LTOK;
#pragma unroll
        for (int h = 0; h < 4; ++h) {
            const int col = h * 512 + lane * 8;
            const u32x4 ov = ovv[h];
            float o[8] = {lo_f(ov.x), hi_f(ov.x), lo_f(ov.y), hi_f(ov.y), lo_f(ov.z), hi_f(ov.z), lo_f(ov.w), hi_f(ov.w)};
            if (t < 256) { const u32x4 cv = *(const u32x4*)(OCB + (size_t)(b * 256 + t) * 2048 + col);
                o[0] += lo_f(cv.x); o[1] += hi_f(cv.x); o[2] += lo_f(cv.y); o[3] += hi_f(cv.y); o[4] += lo_f(cv.z); o[5] += hi_f(cv.z); o[6] += lo_f(cv.w); o[7] += hi_f(cv.w); }
            float mean = 0.f;
            if (center) { float sm = 0.f;
#pragma unroll
                for (int e = 0; e < 8; ++e) sm += o[e];
                mean = wsum(sm, lane) * (1.f / 512.f); }
            float q = 0.f;
#pragma unroll
            for (int e = 0; e < 8; ++e) { o[e] -= mean; q += o[e] * o[e]; }
            const float rstd = rsqrtf(wsum(q, lane) * (1.f / 512.f) + 1e-6f);
            const u32x4 zv = zvv[h];
            const float z[8] = {lo_f(zv.x), hi_f(zv.x), lo_f(zv.y), hi_f(zv.y), lo_f(zv.z), hi_f(zv.z), lo_f(zv.w), hi_f(zv.w)};
            const f32x4 w0 = hwv[h][0], w1 = hwv[h][1];
            float y[8];
#pragma unroll
            for (int e = 0; e < 8; ++e) y[e] = o[e] * rstd * (e < 4 ? w0[e] : w1[e - 4]) * siluf(z[e]);
            u32x4 w; w.x = pack2(y[0], y[1]); w.y = pack2(y[2], y[3]); w.z = pack2(y[4], y[5]); w.w = pack2(y[6], y[7]);
            *(u32x4*)(Yg + (size_t)row * 2048 + col) = w;
        }
    };
    const int stride = gridDim.x * 8;
    for (int rowa = blockIdx.x * 8 + wid; rowa < MTOK; rowa += 2 * stride) {
        const int rowb0 = rowa + stride; const bool hb = rowb0 < MTOK; const int rowb = hb ? rowb0 : rowa;
        u32x4 oa[4], za[4], ob[4], zb[4];
#pragma unroll
        for (int h = 0; h < 4; ++h) { const int col = h * 512 + lane * 8;
            oa[h] = *(const u32x4*)(Og + (size_t)rowa * 2048 + col); za[h] = *(const u32x4*)(Z + (size_t)rowa * 2048 + col);
            ob[h] = *(const u32x4*)(Og + (size_t)rowb * 2048 + col); zb[h] = *(const u32x4*)(Z + (size_t)rowb * 2048 + col); }
        proc(rowa, oa, za);
        if (hb) proc(rowb, ob, zb);
    }
}

DI void phase_final(const Params& pin) {
    const PP p = launder(pin);
    const int tid = otid(), wid = tid >> 6, lane = tid & 63;
    const float* nw = tin(p, 37);
    f32x4 nw4[4];
#pragma unroll
    for (int i = 0; i < 4; ++i) nw4[i] = *(const f32x4*)(nw + lane * 4 + 256 * i);
    const int stride = gridDim.x * 8, NR = 8 * 4096;
    for (int rowa = blockIdx.x * 8 + wid; rowa < NR; rowa += 2 * stride) {
        const int rowb0 = rowa + stride; const bool hb = rowb0 < NR; const int rowb = hb ? rowb0 : rowa;
        float* hpa = p.out + (size_t)rowa * 1024; float* hpb = p.out + (size_t)rowb * 1024;
        f32x4 xa[4], xb[4]; float sa = 0.f, sb = 0.f;
#pragma unroll
        for (int i = 0; i < 4; ++i) { xa[i] = *(const f32x4*)(hpa + lane * 4 + 256 * i); xb[i] = *(const f32x4*)(hpb + lane * 4 + 256 * i); }
#pragma unroll
        for (int i = 0; i < 4; ++i) { sa += xa[i][0] * xa[i][0] + xa[i][1] * xa[i][1] + xa[i][2] * xa[i][2] + xa[i][3] * xa[i][3]; sb += xb[i][0] * xb[i][0] + xb[i][1] * xb[i][1] + xb[i][2] * xb[i][2] + xb[i][3] * xb[i][3]; }
        sa = wsum(sa, lane); sb = wsum(sb, lane);
        const float ra = rsqrtf(sa * (1.f / 1024.f) + 1e-6f), rb = rsqrtf(sb * (1.f / 1024.f) + 1e-6f);
#pragma unroll
        for (int i = 0; i < 4; ++i) { *(f32x4*)(hpa + lane * 4 + 256 * i) = xa[i] * ra * nw4[i]; if (hb) *(f32x4*)(hpb + lane * 4 + 256 * i) = xb[i] * rb * nw4[i]; }
    }
}

__global__ void __launch_bounds__(512, 2) fwd_megakernel(Params p) {
    extern __shared__ __attribute__((aligned(16))) unsigned char shm[];
    lds_t lds = (lds_t)shm;
    cg::grid_group grid = cg::this_grid();
    const int G = gridDim.x, bid = blockIdx.x;
    volatile LAS unsigned* xst = (volatile LAS unsigned*)(lds + LDS_BYTES - 16);
    if (threadIdx.x == 0) { xst[0] = 0u; xst[1] = 0u; }
    __syncthreads();
    (void)xcd_barrier_post((unsigned*)(p.ws + OFF_BAR), xst);
    for (int rep = 0; rep < REP_P0; ++rep) phase0(p, lds);
    if (gridDim.x > 0x40000000u) grid.sync();
    xcd_barrier(p, lds);
    for (int l = 0; l < 4; ++l) {
        const int kind = lkind(l);
        const int nqk = kind == 1 ? 1024 : 2048;
        for (int rep = 0; rep < REP_P1F; ++rep) phase_p1(p, lds, l, true);
        xcd_barrier(p, lds);
        {
            if (kind == 0) { for (int it = (bid + G - 128 % G) % G; it < 32; it += G) mlstm_chain(p, lds, it >> 2, it & 3); }
            const PP q = launder(p); const bf16_t* WT = (const bf16_t*)(q.ws + off_wt(l));
            pg8::Gemm g{(const bf16_t*)(q.ws + OFF_RQ), WT, MTOK, nqk, 1024};
            pg8::StaticOrder S; S.init(g.M, g.N, G, bid);
            pg8::EpiBf16 E{(bf16_t*)(q.ws + OFF_RO), nqk};
            for (int rep = 0; rep < REP_GEMM; ++rep) pg8::gemm_phase(lds, g, S, E);
        }
        {
            const PP q = launder(p); const bf16_t* WT = (const bf16_t*)(q.ws + off_wt(l));
            pg8::Gemm g{WT + (size_t)nqk * 1024, (const bf16_t*)(q.ws + OFF_RQ), 2048, MTOK, 1024};
            pg8::StaticOrder S; S.init(g.M, g.N, G, (bid + G - (kind == 1 ? 128 : 64) % G) % G);
            pg8::EpiBf16 E{(bf16_t*)(q.ws + OFF_R0), MTOK};
            for (int rep = 0; rep < REP_GEMM; ++rep) pg8::gemm_phase(lds, g, S, E);
        }
        xcd_barrier(p, lds);
        for (int rep = 0; rep < REP_P3; ++rep) { if (kind == 0) phase_p3<256, 0>(p, lds, l); else if (kind == 1) phase_p3<128, 1>(p, lds, l); else phase_p3<256, 2>(p, lds, l); }
        xcd_barrier(p, lds);
        for (int rep = 0; rep < REP_SCAN; ++rep) { if (rep) xcd_barrier(p, lds); if (kind == 1) phase_scan<128>(p, lds, kind); else phase_scan<256>(p, lds, kind); }
        xcd_barrier(p, lds);
        for (int rep = 0; rep < REP_P1; ++rep) phase_p1(p, lds, l, false);
        xcd_barrier(p, lds);
        {
            const PP q = launder(p); const bf16_t* WT = (const bf16_t*)(q.ws + off_wt(l));
            pg8::Gemm g{(const bf16_t*)(q.ws + OFF_RQ), WT + (size_t)(nqk + 2048) * 1024, MTOK, 2048, 1024};
            pg8::StaticOrder S; S.init(g.M, g.N, G, bid, l == 3 ? 1 : 0);
#ifdef FUSE_GATE
            pg8::EpiGate E{(bf16_t*)(q.ws + OFF_RO), (const bf16_t*)(q.ws + OFF_OCB), (const f32x2*)(q.ws + OFF_STATS), tin(q, lbase(l) + (kind == 0 ? 7 : (kind == 1 ? 6 : 5)))};
            pg8::gemm_phase(lds, g, S, E);
        }
        xcd_barrier(p, lds);
#else
            pg8::EpiBf16 E{(bf16_t*)(q.ws + OFF_R0), 2048};
            pg8::gemm_phase(lds, g, S, E);
        }
        if (l < 3) weights_prep(p, lds, l + 1, G >= 128 ? 64 : 0);
        xcd_barrier(p, lds);
        for (int rep = 0; rep < REP_P5D; ++rep) phase_p5(p, l, true);
        phase_p5(p, l, false);
        xcd_barrier(p, lds);
#endif
        {
            const PP q = launder(p);
            pg8::Gemm g{(const bf16_t*)(q.ws + OFF_RO), (const bf16_t*)(q.ws + off_wo(l)), MTOK, 1024, 2048};
            pg8::StaticOrder S; S.init(g.M, g.N, G, bid, l == 3 ? 1 : 0);
            { pg8::EpiNull E0{(float*)(q.ws + OFF_STATS)}; for (int rep = 0; rep < REP_OUTD; ++rep) pg8::gemm_phase(lds, g, S, E0); }
            pg8::EpiRes E{q.out, (float*)(q.ws + OFF_HCTX), (const float*)(q.ws + OFF_ADA) + (size_t)l * 9 * 3072, l == 3 ? 1 : 0, l == 0 ? tin(q, 0) : nullptr, l == 0 ? tin(q, 2) : nullptr};
            pg8::gemm_phase(lds, g, S, E);
        }
        xcd_barrier(p, lds);
    }
    for (int rep = 0; rep < REP_SYNC; ++rep) xcd_barrier(p, lds);
    phase_final(p);
}

extern "C" void kernel_launch(void* const* d_in, const int* in_sizes, int n_in, void* d_out, int out_size, void* d_ws, size_t ws_size, hipStream_t stream) {
    static int grid = 0;
    if (grid == 0) {
        if (n_in != 38 || ws_size < WS_END) { fprintf(stderr, "kernel_launch: unexpected n_in %d or ws_size %zu (< %zu)\n", n_in, ws_size, (size_t)WS_END); grid = -1; return; }
        int dev = 0, cus = 0, per_cu = 0;
        hipGetDevice(&dev);
        hipDeviceGetAttribute(&cus, hipDeviceAttributeMultiprocessorCount, dev);
        if (hipFuncSetAttribute((const void*)fwd_megakernel, hipFuncAttributeMaxDynamicSharedMemorySize, LDS_BYTES) != hipSuccess) { fprintf(stderr, "hipFuncSetAttribute failed\n"); grid = -1; return; }
        hipOccupancyMaxActiveBlocksPerMultiprocessor(&per_cu, (const void*)fwd_megakernel, 512, LDS_BYTES);
        if (per_cu < 1) per_cu = 1;
        (void)hipGetLastError();
        grid = cus * per_cu;
        if (grid > 256) grid = 256;
    }
    if (grid < 0) return;
    (void)hipMemsetAsync((unsigned char*)d_ws + OFF_BAR, 0, 16384, stream);
    Params p{};
    for (int i = 0; i < 38; ++i) p.in[i] = (const float*)d_in[i];
    p.out = (float*)d_out; p.ws = (unsigned char*)d_ws;
    void* args[] = {&p};
    hipError_t e = hipLaunchCooperativeKernel((const void*)fwd_megakernel, dim3(grid), dim3(512), args, LDS_BYTES, stream);
    if (e != hipSuccess) fprintf(stderr, "cooperative launch failed: %s (grid %d)\n", hipGetErrorString(e), grid);
}
```

```cpp
#include <hip/hip_runtime.h>
#include <hip/hip_cooperative_groups.h>
#include <cstdio>
namespace cg = cooperative_groups;

#define LAS __attribute__((address_space(3)))
#define DI __device__ __forceinline__
typedef unsigned short bf16_t;
typedef short bf16x8 __attribute__((ext_vector_type(8)));
typedef short s16x4 __attribute__((ext_vector_type(4)));
typedef float f32x4 __attribute__((ext_vector_type(4)));
typedef float f32x2 __attribute__((ext_vector_type(2)));
typedef unsigned u32x4 __attribute__((ext_vector_type(4)));
typedef unsigned u32x2 __attribute__((ext_vector_type(2)));
typedef __bf16 bfv2 __attribute__((ext_vector_type(2)));
typedef LAS unsigned char* lds_t;

constexpr int MTOK = 34816, LTOK = 4352, NCHK = 68;
constexpr size_t SZ_BIG = (size_t)MTOK * 2048 * 2;
constexpr size_t OFF_R0 = 0;
constexpr size_t OFF_RO = SZ_BIG;
constexpr size_t OFF_RQ = 2 * SZ_BIG;
constexpr size_t OFF_RK = OFF_RQ + SZ_BIG / 2;
constexpr size_t OFF_RS = OFF_RK + SZ_BIG / 2;
constexpr size_t SZ_S = (size_t)2 * 8 * 4 * 68 * 4096 * 2;
constexpr size_t OFF_HCTX = OFF_RS + SZ_S;
constexpr size_t OFF_WT = OFF_HCTX + (size_t)8 * 256 * 1024 * 4;
constexpr size_t OFF_WO = OFF_WT + (size_t)6144 * 1024 * 2;
constexpr size_t OFF_GATES = OFF_WO + (size_t)1024 * 2048 * 2;
constexpr size_t SZ_SCAL = (size_t)2 * 8 * 4 * LTOK * 4;
constexpr size_t OFF_SA = OFF_GATES + (size_t)MTOK * 32 * 4;
constexpr size_t OFF_SC = OFF_SA + SZ_SCAL;
constexpr size_t OFF_SR = OFF_SC + SZ_SCAL;
constexpr size_t OFF_SF = OFF_SR + SZ_SCAL;
constexpr size_t OFF_SK = OFF_SF + SZ_SCAL;
constexpr size_t OFF_RSUM = OFF_SK + SZ_SCAL;
constexpr size_t OFF_DECS = OFF_RSUM + SZ_SCAL;
constexpr size_t OFF_DEC = OFF_DECS + 32768;
constexpr size_t OFF_ADA = OFF_DEC + (size_t)2 * 8 * 4 * 68 * 128 * 4;
constexpr size_t OFF_OCB = OFF_ADA + (size_t)4 * 9 * 3072 * 4;
constexpr size_t OFF_TAB = OFF_OCB + (size_t)8 * 256 * 2048 * 2;
constexpr size_t OFF_BAR = OFF_TAB + 4096;
constexpr size_t OFF_STATS = OFF_BAR + 16384;
constexpr size_t OFF_WT2 = OFF_STATS + (size_t)MTOK * 4 * 8;
constexpr size_t OFF_WO2 = OFF_WT2 + (size_t)6144 * 1024 * 2;
constexpr size_t WS_END = OFF_WO2 + (size_t)1024 * 2048 * 2;
constexpr int LDS_BYTES = 147456;

#ifndef REP_GEMM
#define REP_GEMM 1
#endif
#ifndef REP_SCAN
#define REP_SCAN 1
#endif
#ifndef REP_P3
#define REP_P3 1
#endif
#ifndef REP_SYNC
#define REP_SYNC 0
#endif
#ifndef REP_P5D
#define REP_P5D 0
#endif
#ifndef REP_OUTD
#define REP_OUTD 0
#endif
#ifndef REP_P0
#define REP_P0 1
#endif
#ifndef REP_P1F
#define REP_P1F 1
#endif
#ifndef REP_P1
#define REP_P1 1
#endif
struct Params { const float* in[38]; float* out; unsigned char* ws; };

DI int otid() { int t = threadIdx.x; asm volatile("" : "+v"(t)); return t; }
DI int obid() { int t = blockIdx.x; asm volatile("" : "+s"(t)); return t; }
struct PP { float* out; unsigned char* ws; };
DI PP launder(const Params& p) { PP q; q.out = p.out; q.ws = p.ws; asm volatile("" : "+s"(q.out), "+s"(q.ws)); return q; }
DI PP launder(const PP& p) { PP q = p; asm volatile("" : "+s"(q.out), "+s"(q.ws)); return q; }
DI size_t off_wt(int l) { return (l & 1) ? OFF_WT2 : OFF_WT; }
DI size_t off_wo(int l) { return (l & 1) ? OFF_WO2 : OFF_WO; }
DI const float* tin(const PP& p, int i) { return ((const float* const*)(p.ws + OFF_TAB))[i]; }
DI float bf2f(unsigned b) { return __uint_as_float(b << 16); }
DI unsigned pack2(float a, float b) { f32x2 f = {a, b}; bfv2 r = __builtin_convertvector(f, bfv2); return __builtin_bit_cast(unsigned, r); }
DI bf16_t f2bf(float a) { return (bf16_t)(pack2(a, 0.f) & 0xffffu); }
DI float lo_f(unsigned w) { return __uint_as_float(w << 16); }
DI float hi_f(unsigned w) { return __uint_as_float(w & 0xffff0000u); }
DI float dot2(unsigned a, unsigned b, float c) { return __builtin_amdgcn_fdot2_f32_bf16(__builtin_bit_cast(bfv2, a), __builtin_bit_cast(bfv2, b), c, false); }
DI int swz16x32(int ob) { return ob ^ (((ob >> 9) & 1) << 5); }
DI float siluf(float v) { return v / (1.f + __expf(-v)); }
DI float logsig(float x) { return fminf(x, 0.f) - __logf(1.f + __expf(-fabsf(x))); }
DI int lbase(int l) { return l == 0 ? 4 : (l == 1 ? 13 : (l == 2 ? 21 : 28)); }
DI int lkind(int l) { return l == 1 ? 1 : (l == 2 ? 2 : 0); }
DI float shx(float v, int mask, int lane) { return __int_as_float(__builtin_amdgcn_ds_bpermute((lane ^ mask) << 2, __float_as_int(v))); }
DI float shup(float v, int o, int lane) { return __int_as_float(__builtin_amdgcn_ds_bpermute((lane - o) << 2, __float_as_int(v))); }
DI float dpp_add(float v, const int ctrl) { return v; }
#define DPP_ADD(v, ctrl) ((v) + __int_as_float(__builtin_amdgcn_update_dpp(0, __float_as_int(v), (ctrl), 0xf, 0xf, true)))
DI float wsum(float v, int lane) {
    (void)lane;
    v = DPP_ADD(v, 0xB1);
    v = DPP_ADD(v, 0x4E);
    v = DPP_ADD(v, 0x141);
    v = DPP_ADD(v, 0x140);
    const int vi = __float_as_int(v);
    const float r0 = __int_as_float(__builtin_amdgcn_readlane(vi, 0)), r1 = __int_as_float(__builtin_amdgcn_readlane(vi, 16));
    const float r2 = __int_as_float(__builtin_amdgcn_readlane(vi, 32)), r3 = __int_as_float(__builtin_amdgcn_readlane(vi, 48));
    return (r0 + r1) + (r2 + r3);
}
DI const float* hrow(const PP& p, int row, int l) {
    const int b = row / LTOK, t = row - b * LTOK;
    if (l == 0) return t < 256 ? tin(p, 2) + (size_t)(b * 256 + t) * 1024 : tin(p, 0) + (size_t)(b * 4096 + t - 256) * 1024;
    return t < 256 ? (const float*)(p.ws + OFF_HCTX) + (size_t)(b * 256 + t) * 1024 : p.out + (size_t)(b * 4096 + t - 256) * 1024;
}

#define XB_TMO      128
#define XB_XCNT(j)  (256  + 64 * (j))
#define XB_XSUB(j)  (1280 + 64 * (j))
#define XB_XGEN(j)  (2304 + 64 * (j))
#define XB_TOP      3328
#define XB_TOPGEN   3392
#define XCD_BAR_WORDS 3456
#define XB_SPIN_CAP (1u << 22)
DI unsigned xb_ld(unsigned* p)              { return __hip_atomic_load(p, __ATOMIC_RELAXED, __HIP_MEMORY_SCOPE_AGENT); }
DI unsigned xb_add(unsigned* p, unsigned v) { return __hip_atomic_fetch_add(p, v, __ATOMIC_RELAXED, __HIP_MEMORY_SCOPE_AGENT); }
DI unsigned xb_xcc_id() { return (unsigned)__builtin_amdgcn_s_getreg((3 << 11) | 20) & 0xFu; }
#define XB_SPIN(cond, bar) do { unsigned _sp = 0; while (cond) { __builtin_amdgcn_s_sleep(1); \
    if ((++_sp & 255u) == 0u) { if (xb_ld(&(bar)[XB_TMO])) break; if (_sp > XB_SPIN_CAP) { atomicAdd(&(bar)[XB_TMO], 1u); break; } } } } while (0)
struct XcdBarrier { unsigned* bar; unsigned x; volatile LAS unsigned* st; };
DI XcdBarrier xcd_barrier_post(unsigned* bar, volatile LAS unsigned* st) {
    XcdBarrier b; b.bar = bar; b.x = xb_xcc_id(); b.st = st;
    if (threadIdx.x == 0) (void)xb_add(&bar[XB_XCNT(b.x)], 1u);
    return b;
}
DI void xcd_barrier_complete(unsigned* bar, unsigned x, unsigned& nloc, unsigned& nx) {
    const unsigned G = gridDim.x * gridDim.y * gridDim.z;
    unsigned sum, cnt, mine, sp = 0u;
    for (;;) {
        sum = 0u; cnt = 0u; mine = 0u;
#pragma unroll
        for (unsigned j = 0; j < 16; ++j) { const unsigned c = xb_ld(&bar[XB_XCNT(j)]); sum += c; cnt += (c > 0u) ? 1u : 0u; mine = (j == x) ? c : mine; }
        if (sum == G) break;
        __builtin_amdgcn_s_sleep(1);
        if ((++sp & 255u) == 0u) { if (xb_ld(&bar[XB_TMO])) break; if (sp > XB_SPIN_CAP) { atomicAdd(&bar[XB_TMO], 1u); break; } }
    }
    nloc = mine > 0u ? mine : 1u; nx = cnt > 0u ? cnt : 1u;
}
DI void xcd_barrier(const Params& pin, lds_t lds) {
    const PP p = launder(pin);
    XcdBarrier b; b.bar = (unsigned*)(p.ws + OFF_BAR); b.st = (volatile LAS unsigned*)(lds + LDS_BYTES - 16);
    asm volatile("s_waitcnt vmcnt(0)" ::: "memory");
    __syncthreads();
    if (threadIdx.x == 0) {
        unsigned* bar = b.bar; b.x = xb_xcc_id();
        __builtin_amdgcn_s_waitcnt(0);
        unsigned nloc = b.st[0], nx = b.st[1];
        if (nloc == 0u) { xcd_barrier_complete(bar, b.x, nloc, nx); b.st[0] = nloc; b.st[1] = nx; }
        const unsigned old = xb_add(&bar[XB_XSUB(b.x)], 1u);
        const unsigned gen = old / nloc;
        if (old + 1u == (gen + 1u) * nloc) {
            __builtin_amdgcn_fence(__ATOMIC_RELEASE, "agent");
            asm volatile("s_waitcnt vmcnt(0)" ::: "memory");
            const unsigned og = xb_add(&bar[XB_TOP], 1u);
            const unsigned tg = og / nx;
            if (og + 1u == (tg + 1u) * nx) xb_add(&bar[XB_TOPGEN], 1u);
            else XB_SPIN(xb_ld(&bar[XB_TOPGEN]) == tg, bar);
            __builtin_amdgcn_fence(__ATOMIC_ACQUIRE, "agent");
            xb_add(&bar[XB_XGEN(b.x)], 1u);
            asm volatile("s_waitcnt vmcnt(0)" ::: "memory");
        } else {
            XB_SPIN(xb_ld(&bar[XB_XGEN(b.x)]) == gen, bar);
            __builtin_amdgcn_fence(__ATOMIC_ACQUIRE, "agent");
            asm volatile("s_waitcnt vmcnt(0)" ::: "memory");
        }
    }
    __syncthreads();
}

#define MFMA16(a, b, c) __builtin_amdgcn_mfma_f32_16x16x32_bf16((a), (b), (c), 0, 0, 0)

namespace pg8 {
constexpr int BM = 256, BK = 64, HALF = 128, HTB = HALF * BK * 2, NXCD = 8, WGM = 8;
DI int lds_byte(int r, int c) { const int st = (r >> 4) * 2 + (c >> 5), rr = r & 15, cc = c & 31, ob = rr * 64 + cc * 2; return st * 1024 + (ob ^ (((ob >> 9) & 1) << 5)); }
DI void stage_rc(int b, int& R, int& C) { const int st = b / 1024, sb = b % 1024, swz = sb ^ (((sb >> 9) & 1) << 5); R = (st >> 1) * 16 + swz / 64; C = (st & 1) * 32 + (swz % 64) / 2; }
DI int perm32(int rho) { const int n = rho >> 4, i = rho & 15; return 8 * (i >> 2) + 4 * n + (i & 3); }
struct Unit { int pm, pn; };
struct Gemm { const bf16_t* A; const bf16_t* Bt; int M, N, K; };
struct StaticOrder {
    int nM, nN, nwg, G, c, skipctx;
    DI void init(int M, int N, int G_, int c_, int skipctx_ = 0) { skipctx = skipctx_; nM = skipctx_ ? 128 : M / BM; nN = N / BM; nwg = nM * nN; G = G_; c = c_; }
    DI bool next(int i, Unit& u) const {
        const long L = (long)i * G + c; if (L >= nwg) return false;
        int wgid = (int)L; { const int q = nwg / NXCD, r = nwg % NXCD, xcd = wgid % NXCD, off = wgid / NXCD; wgid = (xcd < r ? xcd * (q + 1) : r * (q + 1) + (xcd - r) * q) + off; }
        const int nig = WGM * nN, gid = wgid / nig, fm = gid * WGM, gsz = (nM - fm) < WGM ? (nM - fm) : WGM;
        u.pm = fm + ((wgid % nig) % gsz); u.pn = (wgid % nig) / gsz; if (skipctx) u.pm += u.pm / 16 + 1; return true;
    }
};

template <class Epi>
DI void gemm_phase(lds_t lds, const Gemm g, const StaticOrder& S, const Epi& E) {
    const int tid = otid(), wid = __builtin_amdgcn_readfirstlane(tid >> 6), lane = tid & 63, wr = wid >> 2, wc = wid & 3, fr = lane & 15, fq = lane >> 4;
    const int K = g.K, nt = K / BK;
    unsigned voffA[2], voffB[2];
#pragma unroll
    for (int i = 0; i < 2; ++i) { int R, C; stage_rc(tid * 16 + i * 8192, R, C); const int Rb = Epi::PERM ? ((R & ~31) + perm32(R & 31)) : R;
        voffA[i] = (unsigned)(R * K + C) * 2u; voffB[i] = (unsigned)(Rb * K + C) * 2u; }
    const size_t kstep = (size_t)(BK * 2);
    const size_t hstep = (size_t)HALF * K * 2;
    const size_t tstep = 2 * hstep;
    const unsigned ldsw = (unsigned)wid * 1024u;
    const int aoff = lds_byte(wr * 64 + fr, fq * 8), boff = lds_byte(wc * 32 + fr, fq * 8);
#define PG8_SA(b, h) (((b) * 2 + (h)) * HTB)
#define PG8_SB(b, h) ((4 + (b) * 2 + (h)) * HTB)
#define PG8_STAGE(bufoff, gbase, voff) do { _Pragma("unroll") for (int _i = 0; _i < 2; ++_i) \
        __builtin_amdgcn_global_load_lds((const unsigned*)((const char*)(gbase) + (voff)[_i]), (LAS unsigned*)(lds + (bufoff) + ldsw + _i * 8192), 16, 0, 0); } while (0)
#define PG8_LDA(dst, b, h) do { _Pragma("unroll") for (int m = 0; m < 4; ++m) _Pragma("unroll") for (int k = 0; k < 2; ++k) dst[m][k] = *(const LAS bf16x8*)(lds + PG8_SA(b, h) + aoff + m * 2048 + k * 1024); } while (0)
#define PG8_LDB(dst, b, h) do { _Pragma("unroll") for (int n = 0; n < 2; ++n) _Pragma("unroll") for (int k = 0; k < 2; ++k) dst[n][k] = *(const LAS bf16x8*)(lds + PG8_SB(b, h) + boff + n * 2048 + k * 1024); } while (0)
#define PG8_MMA(ai, bj, At, Bt) do { __builtin_amdgcn_s_setprio(1); _Pragma("unroll") for (int m = 0; m < 4; ++m) _Pragma("unroll") for (int n = 0; n < 2; ++n) _Pragma("unroll") for (int k = 0; k < 2; ++k) \
        acc[ai][bj][m][n] = __builtin_amdgcn_mfma_f32_16x16x32_bf16(Bt[n][k], At[m][k], acc[ai][bj][m][n], 0, 0, 0); __builtin_amdgcn_s_setprio(0); } while (0)
#define PG8_WAIT_V(n) asm volatile("s_waitcnt vmcnt(" #n ")" ::: "memory")
#define PG8_WAIT_L(n) asm volatile("s_waitcnt lgkmcnt(" #n ")" ::: "memory")
#define PG8_BAR __builtin_amdgcn_s_barrier()
#define PG8_SCHED __builtin_amdgcn_sched_barrier(0)
    Unit cur, nxt; int ui = 0;
    if (!S.next(0, cur)) return;
#ifdef GEMM_STAGGER
    if ((blockIdx.x >> 3) & 1) { const unsigned long long t0 = __builtin_amdgcn_s_memrealtime(); while (__builtin_amdgcn_s_memrealtime() - t0 < GEMM_STAGGER) __builtin_amdgcn_s_sleep(8); }
#endif
    f32x4 acc[2][2][4][2];
#pragma unroll
    for (int a = 0; a < 2; ++a)
#pragma unroll
        for (int b = 0; b < 2; ++b)
#pragma unroll
            for (int m = 0; m < 4; ++m)
#pragma unroll
                for (int n = 0; n < 2; ++n) acc[a][b][m][n] = (f32x4){0.f, 0.f, 0.f, 0.f};
    bf16x8 At[4][2], B0[2][2], B1[2][2];
    const char* cA = (const char*)g.A + (size_t)cur.pm * tstep; const char* cB = (const char*)g.Bt + (size_t)cur.pn * tstep;
    PG8_STAGE(PG8_SB(0, 0), cB, voffB); PG8_STAGE(PG8_SA(0, 0), cA, voffA); PG8_STAGE(PG8_SB(0, 1), cB + hstep, voffB); PG8_STAGE(PG8_SA(0, 1), cA + hstep, voffA);
    if (wr == 1) PG8_BAR;
    PG8_WAIT_V(4); PG8_BAR;
    PG8_STAGE(PG8_SB(1, 0), cB + kstep, voffB); PG8_STAGE(PG8_SA(1, 0), cA + kstep, voffA); PG8_STAGE(PG8_SB(1, 1), cB + hstep + kstep, voffB);
    PG8_WAIT_V(6); PG8_BAR;
    for (;;) {
        const bool has_next = S.next(ui + 1, nxt);
        const char* nA = has_next ? (const char*)g.A + (size_t)nxt.pm * tstep : cA; const char* nB = has_next ? (const char*)g.Bt + (size_t)nxt.pn * tstep : cB;
        for (int t = 0; t < nt; t += 2) {
            const bool last = (t == nt - 2);
            const char* a1 = cA + (size_t)(t + 1) * kstep;
            const char* a2 = last ? nA : cA + (size_t)(t + 2) * kstep; const char* b2 = last ? nB : cB + (size_t)(t + 2) * kstep;
            const char* a3 = a2 + kstep; const char* b3 = b2 + kstep;
            PG8_LDB(B0, 0, 0); PG8_SCHED; PG8_LDA(At, 0, 0); PG8_STAGE(PG8_SA(1, 1), a1 + hstep, voffA);
            PG8_WAIT_L(8); PG8_BAR; PG8_WAIT_L(0); PG8_MMA(0, 0, At, B0); PG8_BAR; PG8_SCHED;
            PG8_LDB(B1, 0, 1); PG8_STAGE(PG8_SB(0, 0), b2, voffB);
            PG8_BAR; PG8_WAIT_L(0); PG8_MMA(0, 1, At, B1); PG8_BAR;
            PG8_LDA(At, 0, 1); PG8_STAGE(PG8_SA(0, 0), a2, voffA);
            PG8_BAR; PG8_WAIT_L(0); PG8_MMA(1, 0, At, B0); PG8_BAR; PG8_SCHED;
            PG8_STAGE(PG8_SB(0, 1), b2 + hstep, voffB);
            PG8_WAIT_V(6); PG8_BAR; PG8_MMA(1, 1, At, B1); PG8_BAR;
            PG8_LDB(B0, 1, 0); PG8_SCHED; PG8_LDA(At, 1, 0); PG8_STAGE(PG8_SA(0, 1), a2 + hstep, voffA);
            PG8_WAIT_L(8); PG8_BAR; PG8_WAIT_L(0); PG8_MMA(0, 0, At, B0); PG8_BAR; PG8_SCHED;
            PG8_LDB(B1, 1, 1); PG8_STAGE(PG8_SB(1, 0), b3, voffB);
            PG8_BAR; PG8_WAIT_L(0); PG8_MMA(0, 1, At, B1); PG8_BAR;
            PG8_LDA(At, 1, 1); PG8_STAGE(PG8_SA(1, 0), a3, voffA);
            PG8_BAR; PG8_WAIT_L(0); PG8_MMA(1, 0, At, B0); PG8_BAR; PG8_SCHED;
            PG8_STAGE(PG8_SB(1, 1), b3 + hstep, voffB);
            PG8_WAIT_V(6); PG8_BAR; PG8_MMA(1, 1, At, B1); PG8_BAR;
        }
        E(acc, cur, wr, wc, fr, fq);
        if (!has_next) break;
#pragma unroll
        for (int a = 0; a < 2; ++a)
#pragma unroll
            for (int b = 0; b < 2; ++b)
#pragma unroll
                for (int m = 0; m < 4; ++m)
#pragma unroll
                    for (int n = 0; n < 2; ++n) acc[a][b][m][n] = (f32x4){0.f, 0.f, 0.f, 0.f};
        cur = nxt; cA = nA; cB = nB; ++ui;
    }
    PG8_WAIT_V(0);
    if (wr == 0) PG8_BAR;
    PG8_BAR;
#undef PG8_SA
#undef PG8_SB
#undef PG8_STAGE
#undef PG8_LDA
#undef PG8_LDB
#undef PG8_MMA
#undef PG8_WAIT_V
#undef PG8_WAIT_L
#undef PG8_BAR
#undef PG8_SCHED
}

struct EpiBf16 {
    static constexpr bool PERM = true;
    bf16_t* O; int ldc;
    DI void operator()(const f32x4 (&acc)[2][2][4][2], const Unit& u, int wr, int wc, int fr, int fq) const {
        const int row0 = u.pm * BM + wr * 64 + fr, col0 = u.pn * BM + wc * 32 + 8 * fq;
#pragma unroll
        for (int ai = 0; ai < 2; ++ai)
#pragma unroll
            for (int m = 0; m < 4; ++m) { bf16_t* rowp = O + (size_t)(row0 + ai * HALF + m * 16) * ldc + col0;
#pragma unroll
                for (int bj = 0; bj < 2; ++bj) { const f32x4 v0 = acc[ai][bj][m][0], v1 = acc[ai][bj][m][1];
                    u32x4 w; w.x = pack2(v0[0], v0[1]); w.y = pack2(v0[2], v0[3]); w.z = pack2(v1[0], v1[1]); w.w = pack2(v1[2], v1[3]);
                    *(u32x4*)(rowp + bj * HALF) = w; } }
    }
};
struct EpiNull { static constexpr bool PERM = false; float* sink;
    DI void operator()(const f32x4 (&acc)[2][2][4][2], const Unit& u, int wr, int wc, int fr, int fq) const { if (acc[0][0][0][0][0] == 12345.678f) sink[0] = 1.f; } };
struct EpiRes {
    static constexpr bool PERM = false;
    float* out; float* hctx; const float* ada_l; int last; const float* xin; const float* cin;
    DI void operator()(const f32x4 (&acc)[2][2][4][2], const Unit& u, int wr, int wc, int fr, int fq) const {
        const int b = u.pm / 17, tt = u.pm % 17;
        float* base; const float* src; const float* g;
        if (tt == 0) { if (last) return; base = hctx + (size_t)b * 256 * 1024; src = cin ? cin + (size_t)b * 256 * 1024 : base; g = ada_l + 8 * 3072 + 2048; }
        else { const size_t o_ = ((size_t)b * 4096 + (size_t)(tt - 1) * 256) * 1024; base = out + o_; src = xin ? xin + o_ : base; g = ada_l + b * 3072 + 2048; }
        const int col0 = u.pn * BM + wc * 32 + 4 * fq;
        f32x4 gv[2][2];
#pragma unroll
        for (int bj = 0; bj < 2; ++bj)
#pragma unroll
            for (int n = 0; n < 2; ++n) gv[bj][n] = *(const f32x4*)(g + col0 + bj * HALF + n * 16);
#pragma unroll
        for (int ai = 0; ai < 2; ++ai) {
            f32x4 hv[4][2][2];
#pragma unroll
            for (int m = 0; m < 4; ++m) { const size_t ro_ = (size_t)(wr * 64 + fr + ai * HALF + m * 16) * 1024 + col0;
#pragma unroll
                for (int bj = 0; bj < 2; ++bj)
#pragma unroll
                    for (int n = 0; n < 2; ++n) hv[m][bj][n] = *(const f32x4*)(src + ro_ + bj * HALF + n * 16); }
#pragma unroll
            for (int m = 0; m < 4; ++m) { const size_t ro_ = (size_t)(wr * 64 + fr + ai * HALF + m * 16) * 1024 + col0;
#pragma unroll
                for (int bj = 0; bj < 2; ++bj)
#pragma unroll
                    for (int n = 0; n < 2; ++n) *(f32x4*)(base + ro_ + bj * HALF + n * 16) = hv[m][bj][n] + gv[bj][n] * acc[ai][bj][m][n]; }
        }
    }
};
struct EpiGate {
    static constexpr bool PERM = true;
    bf16_t* O; const bf16_t* OCB; const f32x2* stats; const float* hw;
    DI void operator()(const f32x4 (&acc)[2][2][4][2], const Unit& u, int wr, int wc, int fr, int fq) const {
        const int row0 = u.pm * BM + wr * 64 + fr, col0 = u.pn * BM + wc * 32 + 8 * fq;
        const int b = u.pm / 17, tt = u.pm % 17;
        f32x4 hwv[2][2];
#pragma unroll
        for (int bj = 0; bj < 2; ++bj) { hwv[bj][0] = *(const f32x4*)(hw + col0 + bj * HALF); hwv[bj][1] = *(const f32x4*)(hw + col0 + bj * HALF + 4); }
#pragma unroll
        for (int ai = 0; ai < 2; ++ai) {
            u32x4 ov[4][2]; f32x2 st[4][2];
#pragma unroll
            for (int m = 0; m < 4; ++m)
#pragma unroll
                for (int bj = 0; bj < 2; ++bj) { const int row = row0 + ai * HALF + m * 16, col = col0 + bj * HALF;
                    ov[m][bj] = *(const u32x4*)(O + (size_t)row * 2048 + col); st[m][bj] = stats[(size_t)row * 4 + (col >> 9)]; }
#pragma unroll
            for (int m = 0; m < 4; ++m)
#pragma unroll
                for (int bj = 0; bj < 2; ++bj) { const int row = row0 + ai * HALF + m * 16, col = col0 + bj * HALF;
                    const u32x4 v = ov[m][bj];
                    float o[8] = {lo_f(v.x), hi_f(v.x), lo_f(v.y), hi_f(v.y), lo_f(v.z), hi_f(v.z), lo_f(v.w), hi_f(v.w)};
                    if (tt == 0) { const u32x4 cv = *(const u32x4*)(OCB + (size_t)(b * 256 + (row - u.pm * BM)) * 2048 + col);
                        o[0] += lo_f(cv.x); o[1] += hi_f(cv.x); o[2] += lo_f(cv.y); o[3] += hi_f(cv.y); o[4] += lo_f(cv.z); o[5] += hi_f(cv.z); o[6] += lo_f(cv.w); o[7] += hi_f(cv.w); }
                    const float mean = st[m][bj].x, rstd = st[m][bj].y;
                    const f32x4 z0 = acc[ai][bj][m][0], z1 = acc[ai][bj][m][1];
                    float y[8];
#pragma unroll
                    for (int e = 0; e < 4; ++e) { y[e] = (o[e] - mean) * rstd * hwv[bj][0][e] * siluf(z0[e]); y[4 + e] = (o[4 + e] - mean) * rstd * hwv[bj][1][e] * siluf(z1[e]); }
                    u32x4 w; w.x = pack2(y[0], y[1]); w.y = pack2(y[2], y[3]); w.z = pack2(y[4], y[5]); w.w = pack2(y[6], y[7]);
                    *(u32x4*)(O + (size_t)row * 2048 + col) = w; }
        }
    }
};
}

DI void phase0(const Params& p, lds_t lds) {
    const int tid = otid(), bid = obid(), G = gridDim.x;
    if (tid == 0) {
#pragma unroll
        for (int i = 0; i < 38; ++i) ((const float**)(p.ws + OFF_TAB))[i] = p.in[i]; }
    LAS float* sc = (LAS float*)lds;
    LAS float* red = sc + 9 * 1024;
    float* ada = (float*)(p.ws + OFF_ADA);
    bool loaded = false;
    for (int it = bid; it < 192; it += G) {
        if (!loaded) { for (int i = tid; i < 9 * 1024; i += 512) { const float v = i < 8192 ? p.in[1][i] : p.in[3][i - 8192]; sc[i] = siluf(v); } __syncthreads(); loaded = true; }
        const int l = it / 48, cb = it % 48, cl = tid & 63, kp = tid >> 6, col = cb * 64 + cl;
        const float* aw = l == 0 ? p.in[5] : (l == 1 ? p.in[14] : (l == 2 ? p.in[22] : p.in[29])); const float* ab = l == 0 ? p.in[6] : (l == 1 ? p.in[15] : (l == 2 ? p.in[23] : p.in[30]));
        float acc[9];
#pragma unroll
        for (int i = 0; i < 9; ++i) acc[i] = 0.f;
        for (int k0 = kp * 128; k0 < kp * 128 + 128; k0 += 16) {
            float w[16];
#pragma unroll
            for (int u = 0; u < 16; ++u) w[u] = aw[(size_t)(k0 + u) * 3072 + col];
#pragma unroll
            for (int u = 0; u < 16; ++u)
#pragma unroll
                for (int i = 0; i < 9; ++i) acc[i] += sc[i * 1024 + k0 + u] * w[u]; }
#pragma unroll
        for (int i = 0; i < 9; ++i) red[(kp * 9 + i) * 64 + cl] = acc[i];
        __syncthreads();
        for (int o = tid; o < 9 * 64; o += 512) { const int i = o >> 6, c = o & 63; float s = 0.f; for (int q = 0; q < 8; ++q) s += red[(q * 9 + i) * 64 + c];
            ada[(size_t)(l * 9 + i) * 3072 + cb * 64 + c] = s + ab[cb * 64 + c]; }
        __syncthreads();
    }
}

DI void transpose_tile(const float* src, int ldsrc, int r0, int c0, bf16_t* dst, int lddst, lds_t lds) {
    LAS float* t = (LAS float*)lds;
    const int tid = otid(), rr = tid >> 3, cs = (tid & 7) * 8;
    const f32x4 a = *(const f32x4*)(src + (size_t)(r0 + rr) * ldsrc + c0 + cs), b = *(const f32x4*)(src + (size_t)(r0 + rr) * ldsrc + c0 + cs + 4);
#pragma unroll
    for (int e = 0; e < 4; ++e) { t[rr * 65 + cs + e] = a[e]; t[rr * 65 + cs + 4 + e] = b[e]; }
    __syncthreads();
    const int c = tid >> 3, rs = (tid & 7) * 8;
    u32x4 w; w.x = pack2(t[(rs + 0) * 65 + c], t[(rs + 1) * 65 + c]); w.y = pack2(t[(rs + 2) * 65 + c], t[(rs + 3) * 65 + c]);
    w.z = pack2(t[(rs + 4) * 65 + c], t[(rs + 5) * 65 + c]); w.w = pack2(t[(rs + 6) * 65 + c], t[(rs + 7) * 65 + c]);
    *(u32x4*)(dst + (size_t)(c0 + c) * lddst + r0 + rs) = w;
    __syncthreads();
}

template <int NG, int STATS>
DI void p1_rows(const PP& pin, lds_t lds, int l, bf16_t* U, const float* inw, int ldin, int goff, const float* gate_b) {
    const PP p = launder(pin);
    const int tid = otid(), wid = tid >> 6, lane = tid & 63;
    LAS float* wT = (LAS float*)lds;
    if (NG > 0) {
        constexpr int NIT = (NG > 0 ? NG : 4) / 2;
        f32x4 wv[NIT];
#pragma unroll
        for (int it = 0; it < NIT; ++it) { const int idx = tid + 512 * it, k = idx / (NG / 4), n4 = (idx % (NG / 4)) * 4; wv[it] = *(const f32x4*)(inw + (size_t)k * ldin + goff + n4); }
#pragma unroll
        for (int it = 0; it < NIT; ++it) { const int idx = tid + 512 * it, k = idx / (NG / 4), n4 = (idx % (NG / 4)) * 4;
            wT[(n4 + 0) * 1024 + k] = wv[it][0]; wT[(n4 + 1) * 1024 + k] = wv[it][1]; wT[(n4 + 2) * 1024 + k] = wv[it][2]; wT[(n4 + 3) * 1024 + k] = wv[it][3]; }
        __syncthreads();
    }
    const float* nw = tin(p, lbase(l)); const float* ada = (const float*)(p.ws + OFF_ADA) + (size_t)l * 9 * 3072;
    float* gates = (float*)(p.ws + OFF_GATES);
    f32x4 nw4[4];
#pragma unroll
    for (int i = 0; i < 4; ++i) nw4[i] = *(const f32x4*)(nw + lane * 4 + 256 * i);
    auto proc = [&](int row, f32x4 (&x)[4], const f32x4 (&shv)[4], const f32x4 (&scv)[4]) {
        const int b = row / LTOK, t = row - b * LTOK;
        float ss = 0.f;
#pragma unroll
        for (int i = 0; i < 4; ++i) ss += x[i][0] * x[i][0] + x[i][1] * x[i][1] + x[i][2] * x[i][2] + x[i][3] * x[i][3];
        ss = wsum(ss, lane); const float rstd = rsqrtf(ss * (1.f / 1024.f) + 1e-6f);
#pragma unroll
        for (int i = 0; i < 4; ++i) { const f32x4 sh = shv[i], scl = scv[i];
            x[i] = x[i] * rstd * nw4[i] * (scl + 1.f) + sh;
            u32x2 w; w.x = pack2(x[i][0], x[i][1]); w.y = pack2(x[i][2], x[i][3]);
            *(u32x2*)(U + (size_t)row * 1024 + lane * 4 + 256 * i) = w; }
        if (STATS) {
            const bf16_t* Og = (const bf16_t*)(p.ws + OFF_RO); const bf16_t* OCB = (const bf16_t*)(p.ws + OFF_OCB); f32x2* stg = (f32x2*)(p.ws + OFF_STATS);
            u32x4 ov[4];
#pragma unroll
            for (int hh = 0; hh < 4; ++hh) ov[hh] = *(const u32x4*)(Og + (size_t)row * 2048 + hh * 512 + lane * 8);
            f32x2 mine = {0.f, 1.f};
#pragma unroll
            for (int hh = 0; hh < 4; ++hh) {
                const int col = hh * 512 + lane * 8;
                float o[8] = {lo_f(ov[hh].x), hi_f(ov[hh].x), lo_f(ov[hh].y), hi_f(ov[hh].y), lo_f(ov[hh].z), hi_f(ov[hh].z), lo_f(ov[hh].w), hi_f(ov[hh].w)};
                if (t < 256) { const u32x4 cv = *(const u32x4*)(OCB + (size_t)(b * 256 + t) * 2048 + col);
                    o[0] += lo_f(cv.x); o[1] += hi_f(cv.x); o[2] += lo_f(cv.y); o[3] += hi_f(cv.y); o[4] += lo_f(cv.z); o[5] += hi_f(cv.z); o[6] += lo_f(cv.w); o[7] += hi_f(cv.w); }
                float mean = 0.f;
                if (STATS == 1) { float sm = 0.f;
#pragma unroll
                    for (int e = 0; e < 8; ++e) sm += o[e];
                    mean = wsum(sm, lane) * (1.f / 512.f); }
                float qq = 0.f;
#pragma unroll
                for (int e = 0; e < 8; ++e) { const float dlt = o[e] - mean; qq += dlt * dlt; }
                const float rs_ = rsqrtf(wsum(qq, lane) * (1.f / 512.f) + 1e-6f);
                if (lane == hh) mine = (f32x2){mean, rs_};
            }
            if (lane < 4) stg[(size_t)row * 4 + lane] = mine;
        }
    };
    auto gates2 = [&](int rowa, const f32x4 (&xa)[4], int rowb, const f32x4 (&xb)[4], bool hb) {
        float va[NG > 0 ? NG : 1], vb[NG > 0 ? NG : 1];
#pragma unroll
        for (int n = 0; n < NG; ++n) { float sa_ = 0.f, sb_ = 0.f;
#pragma unroll
            for (int i = 0; i < 4; ++i) { const f32x4 w = *(const LAS f32x4*)(wT + n * 1024 + lane * 4 + 256 * i);
                sa_ += xa[i][0] * w[0] + xa[i][1] * w[1] + xa[i][2] * w[2] + xa[i][3] * w[3];
                sb_ += xb[i][0] * w[0] + xb[i][1] * w[1] + xb[i][2] * w[2] + xb[i][3] * w[3]; }
            va[n] = sa_; vb[n] = sb_; }
#pragma unroll
        for (int k = 0; k < 6; ++k) { const int m = 32 >> k; const int hf = NG >> (k + 1);
            if (hf >= 1) { const bool up = (lane & m) != 0;
#pragma unroll
                for (int i = 0; i < hf; ++i) { const float ka = up ? va[hf + i] : va[i], sa2 = up ? va[i] : va[hf + i]; va[i] = ka + shx(sa2, m, lane);
                                               const float kb = up ? vb[hf + i] : vb[i], sb2 = up ? vb[i] : vb[hf + i]; vb[i] = kb + shx(sb2, m, lane); } }
            else { va[0] += shx(va[0], m, lane); vb[0] += shx(vb[0], m, lane); }
        }
        const int sh_ = NG == 32 ? 1 : 2, n = lane >> sh_;
        if ((lane & ((1 << sh_) - 1)) == 0) { const float gb = gate_b ? gate_b[n] : 0.f; gates[(size_t)rowa * 32 + n] = va[0] + gb; if (hb) gates[(size_t)rowb * 32 + n] = vb[0] + gb; }
    };
    const int stride = gridDim.x * 8;
    for (int rowa = blockIdx.x * 8 + wid; rowa < MTOK; rowa += 2 * stride) {
        const int rowb = rowa + stride; const bool hb = rowb < MTOK;
        const float* hpa = hrow(p, rowa, l); const float* hpb = hrow(p, hb ? rowb : rowa, l);
        f32x4 xa[4], xb[4], sha[4], sca[4], shb[4], scb[4];
        const int rb_ = hb ? rowb : rowa;
        const int ba_ = rowa / LTOK, ta_ = rowa - ba_ * LTOK, bb_ = rb_ / LTOK, tb_ = rb_ - bb_ * LTOK;
        const float* ada_a = ada + (ta_ < 256 ? 8 : ba_) * 3072; const float* ada_b = ada + (tb_ < 256 ? 8 : bb_) * 3072;
#pragma unroll
        for (int i = 0; i < 4; ++i) { xa[i] = *(const f32x4*)(hpa + lane * 4 + 256 * i); xb[i] = *(const f32x4*)(hpb + lane * 4 + 256 * i);
            sha[i] = *(const f32x4*)(ada_a + lane * 4 + 256 * i); sca[i] = *(const f32x4*)(ada_a + 1024 + lane * 4 + 256 * i);
            shb[i] = *(const f32x4*)(ada_b + lane * 4 + 256 * i); scb[i] = *(const f32x4*)(ada_b + 1024 + lane * 4 + 256 * i); }
        proc(rowa, xa, sha, sca);
        proc(rb_, xb, shb, scb);
        if (NG > 0) gates2(rowa, xa, rowb, xb, hb);
    }
}

DI void weights_prep(const Params& pin, lds_t lds, int l, int first) {
    const PP p = launder(pin);
    const int kind = lkind(l), lb = lbase(l);
    const float* inw = tin(p, lb + 3);
    const int ldin = kind == 0 ? 6160 : (kind == 1 ? 5152 : 6144), nmain = kind == 1 ? 5120 : 6144;
    bf16_t* WT = (bf16_t*)(p.ws + off_wt(l)); bf16_t* WO = (bf16_t*)(p.ws + off_wo(l));
    const float* ow = tin(p, lb + (kind == 0 ? 8 : (kind == 1 ? 7 : 6)));
    const int nt_in = 16 * (nmain / 64), nt_all = nt_in + 32 * 16;
    const int nw = (int)gridDim.x - first;
    if ((int)blockIdx.x < first || nw <= 0) return;
    for (int it = (int)blockIdx.x - first; it < nt_all; it += nw) {
        if (it < nt_in) { const int rt = it % 16, ct = it / 16; transpose_tile(inw, ldin, rt * 64, ct * 64, WT, 1024, lds); }
        else { const int j = it - nt_in, rt = j % 32, ct = j / 32; transpose_tile(ow, 1024, rt * 64, ct * 64, WO, 2048, lds); }
    }
}

DI void phase_p1(const Params& pin, lds_t lds, int l, bool full) {
    const PP p = launder(pin);
    const int kind = lkind(l), lb = lbase(l);
    const float* inw = tin(p, lb + 3);
    const int ldin = kind == 0 ? 6160 : (kind == 1 ? 5152 : 6144), nmain = kind == 1 ? 5120 : 6144;
    if (full) {
        if (l == 0) weights_prep(pin, lds, 0, 0);
        bf16_t* U = (bf16_t*)(p.ws + OFF_RQ);
        if (kind == 0) p1_rows<16, 0>(p, lds, l, U, inw, ldin, 6144, tin(p, lb + 6));
        else if (kind == 1) p1_rows<32, 0>(p, lds, l, U, inw, ldin, 5120, nullptr);
        else p1_rows<0, 0>(p, lds, l, U, inw, ldin, 0, nullptr);
    } else {
#ifdef FUSE_GATE
        if (kind == 1) p1_rows<0, 2>(p, lds, l, (bf16_t*)(p.ws + OFF_RQ), inw, ldin, 0, nullptr);
        else p1_rows<0, 1>(p, lds, l, (bf16_t*)(p.ws + OFF_RQ), inw, ldin, 0, nullptr);
#else
        p1_rows<0, 0>(p, lds, l, (bf16_t*)(p.ws + OFF_RQ), inw, ldin, 0, nullptr);
#endif
    }
}

DI int chunk_of(int dir, int s) { return dir == 0 ? s : (s < 4 ? 3 - s : 71 - s); }

DI void mlstm_chain(const Params& pin, lds_t lds, int b, int h) {
    const PP p = launder(pin);
    const int tid = otid(), wid = tid >> 6, lane = tid & 63;
    LAS float* btok = (LAS float*)lds;
    LAS float* ctok = btok + 2 * LTOK;
    LAS float* ptok = ctok + 2 * LTOK;
    LAS float* Bc = ptok + 2 * LTOK;
    LAS float* PMc = Bc + 136;
    LAS float* Mst = PMc + 136;
    const float* gates = (const float*)(p.ws + OFF_GATES);
    for (int q = wid; q < 136; q += 8) {
        const int dir = q / 68, c = q % 68;
        const int tk = c * 64 + (dir ? 63 - lane : lane);
        const float* gr = gates + (size_t)(b * LTOK + tk) * 32 + dir * 8 + h;
        const float gi = gr[0], lf = logsig(gr[4]);
        float bc = lf;
#pragma unroll
        for (int o = 1; o < 64; o <<= 1) { const float t = shup(bc, o, lane); if (lane >= o) bc += t; }
        const float cc = gi - bc; float pm = cc;
#pragma unroll
        for (int o = 1; o < 64; o <<= 1) { const float t = shup(pm, o, lane); if (lane >= o) pm = fmaxf(pm, t); }
        btok[dir * LTOK + tk] = bc; ctok[dir * LTOK + tk] = cc; ptok[dir * LTOK + tk] = pm;
        if (lane == 63) { Bc[q] = bc; PMc[q] = pm; }
    }
    __syncthreads();
    if (tid < 2) { float m = 0.f; for (int s = 0; s < 68; ++s) { const int c = chunk_of(tid, s); Mst[tid * 68 + c] = m; m = Bc[tid * 68 + c] + fmaxf(m, PMc[tid * 68 + c]); } }
    __syncthreads();
    float* SA = (float*)(p.ws + OFF_SA); float* SC = (float*)(p.ws + OFF_SC); float* SR = (float*)(p.ws + OFF_SR);
    float* SF = (float*)(p.ws + OFF_SF); float* SK = (float*)(p.ws + OFF_SK); float* DECS = (float*)(p.ws + OFF_DECS);
    for (int idx = tid; idx < 2 * LTOK; idx += 512) {
        const int dir = idx / LTOK, tk = idx - dir * LTOK, c = tk >> 6;
        const float mst = Mst[dir * 68 + c], pm = ptok[idx], cc = ctok[idx], bb = btok[idx];
        const float mx = fmaxf(mst, pm), mxe = fmaxf(mst, PMc[dir * 68 + c]);
        const size_t si = (size_t)((dir * 8 + b) * 4 + h) * LTOK + tk;
        SA[si] = -mx; SC[si] = cc; SR[si] = __expf(mst - mx); SF[si] = __expf(-mx - bb); SK[si] = __expf(cc - mxe);
    }
    if (tid < 136) { const int dir = tid / 68, c = tid % 68; const float mst = Mst[tid]; DECS[((dir * 8 + b) * 4 + h) * 68 + c] = __expf(mst - fmaxf(mst, PMc[tid])); }
    __syncthreads();
}

template <int DK, int kind>
DI void phase_p3(const Params& pin, lds_t lds, int l) {
    const PP p = launder(pin);
    constexpr int QSTR = DK * 2 + 16;
    const int tid = otid(), wid = tid >> 6, lane = tid & 63, fr = lane & 15, fq = lane >> 4;
    lds_t Qt = lds, Kt = lds + 64 * QSTR, Kh = lds + 128 * QSTR;
    LAS float* misc = (LAS float*)(lds + 192 * QSTR);
    LAS float* fA = misc; LAS float* fC = misc + 128; LAS float* rsl = misc + 256;
    LAS float* code = misc + 512;
    LAS float* Bc = misc + 512 + 1024;
    LAS float* tot = Bc + 64 * 128;
    const bf16_t* QK = (const bf16_t*)(p.ws + OFF_RO);
    bf16_t* Qs = (bf16_t*)(p.ws + OFF_RQ); bf16_t* KTg = (bf16_t*)(p.ws + OFF_RK); bf16_t* Sg = (bf16_t*)(p.ws + OFF_RS);
    float* SA = (float*)(p.ws + OFF_SA); float* SC = (float*)(p.ws + OFF_SC); float* SR = (float*)(p.ws + OFF_SR);
    float* SK = (float*)(p.ws + OFF_SK); float* RSUM = (float*)(p.ws + OFF_RSUM); float* DECS = (float*)(p.ws + OFF_DECS); float* DEC = (float*)(p.ws + OFF_DEC);
    const int lb = lbase(l);
    for (int it = blockIdx.x; it < 8 * 68 * 4; it += gridDim.x) {
        const int h = it & 3, c = (it >> 2) % 68, b = it / (4 * 68);
        const int row0 = b * LTOK + c * 64;
        const int npass = (kind == 1) ? 2 : 1;
        for (int pass = 0; pass < npass; ++pass) {
            if (kind == 0) {
                const float* cw = tin(p, lb + 4); const float* cbias = tin(p, lb + 5);
                if (tid < 128) { const int dir = tid >> 6, jj = tid & 63; const size_t si = (size_t)((dir * 8 + b) * 4 + h) * LTOK + c * 64 + jj; fA[tid] = SA[si]; fC[tid] = SC[si]; }
                const int pc = tid & 63, x0 = (tid >> 6) * 8, which = pc >> 5, cc0 = (pc & 31) * 8, col = which * 1024 + h * 256 + cc0;
                float acc[8][8];
                { const f32x4 b0 = *(const f32x4*)(cbias + col), b1 = *(const f32x4*)(cbias + col + 4);
#pragma unroll
                  for (int xo = 0; xo < 8; ++xo)
#pragma unroll
                      for (int e = 0; e < 4; ++e) { acc[xo][e] = b0[e]; acc[xo][4 + e] = b1[e]; } }
#pragma unroll
                for (int dy = 0; dy < 3; ++dy) {
                    const int yy = c - 4 + dy - 1;
                    const bool rowok = c >= 4 ? (yy >= 0 && yy < 64) : (dy == 1);
                    if (rowok) {
                        float w[3][8];
#pragma unroll
                        for (int dx = 0; dx < 3; ++dx) { const f32x4 w0 = *(const f32x4*)(cw + (dy * 3 + dx) * 2048 + col), w1 = *(const f32x4*)(cw + (dy * 3 + dx) * 2048 + col + 4);
#pragma unroll
                            for (int e = 0; e < 4; ++e) { w[dx][e] = w0[e]; w[dx][4 + e] = w1[e]; } }
                        const int rbase = c >= 4 ? (b * LTOK + 256 + yy * 64) : (b * LTOK + c * 64);
                        const int lo = c >= 4 ? 0 : -(c * 64), hi = c >= 4 ? 64 : 256 - c * 64;
#pragma unroll
                        for (int xi = -1; xi <= 8; ++xi) {
                            const int x = x0 + xi;
                            u32x4 v = {0u, 0u, 0u, 0u};
                            if (x >= lo && x < hi) v = *(const u32x4*)(QK + (size_t)(rbase + x) * 2048 + col);
                            const float f[8] = {lo_f(v.x), hi_f(v.x), lo_f(v.y), hi_f(v.y), lo_f(v.z), hi_f(v.z), lo_f(v.w), hi_f(v.w)};
#pragma unroll
                            for (int dx = 0; dx < 3; ++dx) { const int xo = xi + 1 - dx;
                                if (xo >= 0 && xo < 8) {
#pragma unroll
                                    for (int e = 0; e < 8; ++e) acc[xo][e] += f[e] * w[dx][e]; } }
                        }
                    }
                }
                const float sc = which ? 0.0625f : 1.f;
#pragma unroll
                for (int xo = 0; xo < 8; ++xo) {
                    float y[8];
#pragma unroll
                    for (int e = 0; e < 8; ++e) y[e] = siluf(acc[xo][e]) * sc;
                    u32x4 w; w.x = pack2(y[0], y[1]); w.y = pack2(y[2], y[3]); w.z = pack2(y[4], y[5]); w.w = pack2(y[6], y[7]);
                    *(LAS u32x4*)((which ? Kt : Qt) + (x0 + xo) * QSTR + cc0 * 2) = w;
                }
            } else if (kind == 2) {
                const float* dl = tin(p, lb + 4);
                if (tid < 128) { const int dir = tid >> 6, jj = tid & 63; const float lg = logsig(dl[dir * 4 + h]); const float fj = (float)jj;
                    fA[tid] = dir == 0 ? fj * lg : -fj * lg; fC[tid] = dir == 0 ? -fj * lg : fj * lg;
                    const size_t si = (size_t)((dir * 8 + b) * 4 + h) * LTOK + c * 64 + jj;
                    SR[si] = dir == 0 ? __expf((fj + 1.f) * lg) : __expf((64.f - fj) * lg);
                    SK[si] = dir == 0 ? __expf((63.f - fj) * lg) : __expf(fj * lg);
                    if (jj == 0) DECS[((dir * 8 + b) * 4 + h) * 68 + c] = __expf(64.f * lg); }
                const int j = tid >> 3, g = tid & 7;
#pragma unroll
                for (int half = 0; half < 2; ++half) {
                    const float pos = half == 0 ? (float)(c - 4) : (float)j;
                    float cs[8], sn[8];
#pragma unroll
                    for (int e = 0; e < 8; ++e) { const int i = g * 8 + e; const float f = exp2f(-(float)i * (13.287712379549449f / 64.f));
                        float rev = pos * f * 0.15915494309189535f; rev -= rintf(rev);
                        cs[e] = c >= 4 ? __builtin_amdgcn_cosf(rev) : 1.f; sn[e] = c >= 4 ? __builtin_amdgcn_sinf(rev) : 0.f; }
#pragma unroll
                    for (int which = 0; which < 2; ++which) {
                        const int col = which * 1024 + h * 256 + half * 128 + g * 8;
                        const u32x4 v1 = *(const u32x4*)(QK + (size_t)(row0 + j) * 2048 + col), v2 = *(const u32x4*)(QK + (size_t)(row0 + j) * 2048 + col + 64);
                        float x1[8] = {lo_f(v1.x), hi_f(v1.x), lo_f(v1.y), hi_f(v1.y), lo_f(v1.z), hi_f(v1.z), lo_f(v1.w), hi_f(v1.w)};
                        float x2[8] = {lo_f(v2.x), hi_f(v2.x), lo_f(v2.y), hi_f(v2.y), lo_f(v2.z), hi_f(v2.z), lo_f(v2.w), hi_f(v2.w)};
                        float o1[8], o2[8]; const float sc = which ? 0.0625f : 1.f;
#pragma unroll
                        for (int e = 0; e < 8; ++e) { o1[e] = (x1[e] * cs[e] - x2[e] * sn[e]) * sc; o2[e] = (x1[e] * sn[e] + x2[e] * cs[e]) * sc; }
                        u32x4 w1, w2; w1.x = pack2(o1[0], o1[1]); w1.y = pack2(o1[2], o1[3]); w1.z = pack2(o1[4], o1[5]); w1.w = pack2(o1[6], o1[7]);
                        w2.x = pack2(o2[0], o2[1]); w2.y = pack2(o2[2], o2[3]); w2.z = pack2(o2[4], o2[5]); w2.w = pack2(o2[6], o2[7]);
                        lds_t dst = (which ? Kt : Qt) + j * QSTR + (half * 128 + g * 8) * 2;
                        *(LAS u32x4*)dst = w1; *(LAS u32x4*)(dst + 128) = w2;
                    }
                }
            } else {
                const int dir = pass;
                const float* gates = (const float*)(p.ws + OFF_GATES);
                const float* w2 = tin(p, lb + 4) + (size_t)dir * 16 * 512; const float* gb = tin(p, lb + 5) + dir * 512;
                for (int idx = tid; idx < 1024; idx += 512) { const int ll = idx >> 4, r = idx & 15; code[idx] = gates[(size_t)(row0 + ll) * 32 + dir * 16 + r]; }
                if (tid < 128) { fA[tid] = 0.f; fC[tid] = 0.f; }
                __syncthreads();
                const int d = tid & 127, g = tid >> 7;
                float wr_[16];
#pragma unroll
                for (int r = 0; r < 16; ++r) wr_[r] = w2[r * 512 + h * 128 + d];
                const float bias = gb[h * 128 + d];
                float run = 0.f;
                for (int q = 0; q < 16; ++q) { const int pp = g * 16 + q, ll = dir ? 63 - pp : pp; float pre = bias;
#pragma unroll
                    for (int r = 0; r < 16; ++r) pre += code[ll * 16 + r] * wr_[r];
                    run += logsig(pre) * (1.f / 16.f); Bc[pp * 128 + d] = run; }
                tot[g * 128 + d] = run;
                __syncthreads();
                float off = 0.f, bend = 0.f;
#pragma unroll
                for (int gg = 0; gg < 4; ++gg) { const float t = tot[gg * 128 + d]; if (gg < g) off += t; bend += t; }
                bf16_t qraw[16], kraw[16];
#pragma unroll
                for (int q = 0; q < 16; ++q) { const int pp = g * 16 + q, ll = dir ? 63 - pp : pp;
                    qraw[q] = QK[(size_t)(row0 + ll) * 1024 + h * 128 + d]; kraw[q] = QK[(size_t)(row0 + ll) * 1024 + 512 + h * 128 + d]; }
#pragma unroll
                for (int q = 0; q < 16; ++q) { const int pp = g * 16 + q, ll = dir ? 63 - pp : pp; const float bf = Bc[pp * 128 + d] + off;
                    const float qv = bf2f(qraw[q]), kv = bf2f(kraw[q]);
                    *(LAS bf16_t*)(Qt + ll * QSTR + d * 2) = f2bf(qv * 0.08838834764831845f * __expf(bf));
                    *(LAS bf16_t*)(Kt + ll * QSTR + d * 2) = f2bf(kv * __expf(-bf));
                    *(LAS bf16_t*)(Kh + ll * QSTR + d * 2) = f2bf(kv * __expf(bend - bf)); }
                if (g == 0) DEC[(size_t)(((dir * 8 + b) * 4 + h) * 68 + c) * 128 + d] = __expf(bend);
            }
            __syncthreads();
            {
                const int rb = wid & 3, cbp = wid >> 2;
                f32x4 a0 = {0.f, 0.f, 0.f, 0.f}, a1 = {0.f, 0.f, 0.f, 0.f};
#pragma unroll
                for (int kk = 0; kk < DK / 32; ++kk) {
                    const bf16x8 A = *(const LAS bf16x8*)(Qt + (16 * rb + fr) * QSTR + kk * 64 + fq * 16);
                    const bf16x8 B0 = *(const LAS bf16x8*)(Kt + (32 * cbp + fr) * QSTR + kk * 64 + fq * 16);
                    const bf16x8 B1 = *(const LAS bf16x8*)(Kt + (32 * cbp + 16 + fr) * QSTR + kk * 64 + fq * 16);
                    a0 = MFMA16(A, B0, a0); a1 = MFMA16(A, B1, a1);
                }
                for (int dd = (kind == 1 ? pass : 0); dd < (kind == 1 ? pass + 1 : 2); ++dd) {
                    bf16_t* St = Sg + (size_t)(((dd * 8 + b) * 4 + h) * 68 + c) * 4096;
                    float rs[4] = {0.f, 0.f, 0.f, 0.f};
#pragma unroll
                    for (int t = 0; t < 2; ++t) { const int ll = 32 * cbp + 16 * t + fr; const float cl = fC[dd * 64 + ll];
#pragma unroll
                        for (int i = 0; i < 4; ++i) { const int j = 16 * rb + 4 * fq + i; const bool ok = dd == 0 ? (ll <= j) : (ll >= j);
                            const float a = t == 0 ? a0[i] : a1[i];
                            const float v = ok ? (kind == 1 ? a : a * __expf(fA[dd * 64 + j] + cl)) : 0.f;
                            const bf16_t hb = f2bf(v); St[j * 64 + ll] = hb; rs[i] += bf2f(hb); } }
                    if (kind == 0) {
#pragma unroll
                        for (int i = 0; i < 4; ++i) { float s = rs[i]; s = DPP_ADD(s, 0xB1); s = DPP_ADD(s, 0x4E); s = DPP_ADD(s, 0x141); s = DPP_ADD(s, 0x140);
                            if (fr == 0) rsl[(dd * 2 + cbp) * 64 + 16 * rb + 4 * fq + i] = s; }
                    }
                }
            }
            if (kind != 1) {
#pragma unroll
                for (int i = 0; i < 4; ++i) { const int pi = tid + 512 * i, j = pi >> 5, d8 = pi & 31;
                    *(u32x4*)(Qs + (size_t)(row0 + j) * 1024 + h * 256 + d8 * 8) = *(const LAS u32x4*)(Qt + j * QSTR + d8 * 16); }
            } else {
#pragma unroll
                for (int i = 0; i < 2; ++i) { const int pi = tid + 512 * i, j = pi >> 4, d8 = pi & 15;
                    *(u32x4*)(Qs + (size_t)pass * MTOK * 512 + (size_t)(row0 + j) * 512 + h * 128 + d8 * 8) = *(const LAS u32x4*)(Qt + j * QSTR + d8 * 16); }
            }
            {
                lds_t Ksrc = kind == 1 ? Kh : Kt;
                bf16_t* KTt = KTg + (size_t)((kind == 1 ? ((pass * 8 + b) * 4 + h) : (b * 4 + h)) * 68 + c) * (DK * 64);
#pragma unroll
                for (int i = 0; i < DK / 64; ++i) { const int pi = tid + 512 * i, d = pi >> 3, l8 = pi & 7;
                    unsigned x[8];
#pragma unroll
                    for (int e = 0; e < 8; ++e) x[e] = *(const LAS bf16_t*)(Ksrc + (l8 * 8 + e) * QSTR + d * 2);
                    u32x4 w; w.x = x[0] | (x[1] << 16); w.y = x[2] | (x[3] << 16); w.z = x[4] | (x[5] << 16); w.w = x[6] | (x[7] << 16);
                    *(u32x4*)(KTt + d * 64 + l8 * 8) = w; }
            }
            __syncthreads();
            if (kind == 0 && tid < 128) { const int dir = tid >> 6, jj = tid & 63;
                RSUM[(size_t)((dir * 8 + b) * 4 + h) * LTOK + c * 64 + jj] = rsl[(dir * 2) * 64 + jj] + rsl[(dir * 2 + 1) * 64 + jj]; }
        }
    }
}

template <int DK>
struct ScanState { f32x4 st[DK / 16]; float nreg; };

template <int DK>
DI void scan_steps(const Params& pin, lds_t lds, int kind, int item, int s_lo, int s_hi, ScanState<DK>& S) {
    const PP p = launder(pin);
    constexpr int QSTR = DK * 2 + 16, NT = DK / 16;
    const int tid = otid(), wid = tid >> 6, lane = tid & 63, fr = lane & 15, fq = lane >> 4;
    const int xcd = item & 7, slot = item >> 3, bh = xcd * 4 + (slot >> 3), sub = slot & 7, dir = sub >> 2, vs = sub & 3, b = bh >> 2, h = bh & 3;
    lds_t Ql = lds, KTl = lds + 64 * QSTR, VTl = KTl + DK * 144, Sl = VTl + 128 * 144;
    LAS float* misc = (LAS float*)(Sl + 64 * 144);
    LAS float* rl = misc; LAS float* rsl = misc + 64; LAS float* fll = misc + 128; LAS float* qnl = misc + 192; LAS float* decl = misc + 256;
    LAS float* nl = misc + 384;
    LAS float* rrl = misc + 896;
    const bf16_t* Qg = (const bf16_t*)(p.ws + OFF_RQ) + (kind == 1 ? (size_t)dir * MTOK * 512 : 0);
    const int ldq = kind == 1 ? 512 : 1024;
    const bf16_t* KTg = (const bf16_t*)(p.ws + OFF_RK); const bf16_t* VT = (const bf16_t*)(p.ws + OFF_R0); const bf16_t* Sg = (const bf16_t*)(p.ws + OFF_RS);
    const float* SR = (const float*)(p.ws + OFF_SR); const float* SF = (const float*)(p.ws + OFF_SF); const float* SK = (const float*)(p.ws + OFF_SK);
    const float* RSUM = (const float*)(p.ws + OFF_RSUM); const float* DECS = (const float*)(p.ws + OFF_DECS); const float* DEC = (const float*)(p.ws + OFF_DEC);
    bf16_t* Og = (bf16_t*)(p.ws + OFF_RO); bf16_t* OCB = (bf16_t*)(p.ws + OFF_OCB);
    const int dbh = (dir * 8 + b) * 4 + h;
    u32x4 pq[DK / 64], pk[DK / 64], pv[2], ps; float pks = 1.f;
    float pr = 1.f, prs = 0.f, pfl = 1.f, pdec = 1.f, pdsc = 1.f;
    const int l8 = tid & 7;
    unsigned voffZ = 0u; asm volatile("" : "+v"(voffZ));
    const int aoff = swz16x32(fr * 64 + fq * 16);
    const unsigned voffO = (unsigned)(fr * 2048 + 16 * wid + 4 * fq) * 2u;
    const unsigned voffF = (unsigned)tid * 4u, voffR = (unsigned)(tid / (DK / 8)) * 4u;
    const unsigned voffQ = (unsigned)((tid / (DK / 8)) * ldq + (tid % (DK / 8)) * 8) * 2u, voffT = (unsigned)tid * 16u, voffV = (unsigned)((tid >> 3) * MTOK + l8 * 8) * 2u;
    const __amdgpu_buffer_rsrc_t rs_ws = __builtin_amdgcn_make_buffer_rsrc((void*)p.ws, (short)0, (int)WS_END, 0x00020000);
    const unsigned qdir_ = (unsigned)OFF_RQ + (kind == 1 ? (unsigned)dir * (unsigned)(MTOK * 512 * 2) : 0u);
#define SCAN_ISSUE(sn) do { \
        const int c_ = chunk_of(dir, (sn)), row0_ = b * LTOK + c_ * 64; const unsigned sidx4_ = (unsigned)(dbh * LTOK + c_ * 64) * 4u; \
        const unsigned qs_ = qdir_ + (unsigned)(row0_ * ldq + h * DK) * 2u; \
        _Pragma("unroll") for (int i = 0; i < DK / 64; ++i) pq[i] = __builtin_amdgcn_raw_buffer_load_b128(rs_ws, voffQ, qs_ + (unsigned)(i * (4096 / DK) * ldq * 2), 0); \
        const unsigned ks_ = (unsigned)OFF_RK + (unsigned)(((kind == 1 ? dbh : (b * 4 + h)) * 68 + c_) * (DK * 64)) * 2u; \
        _Pragma("unroll") for (int i = 0; i < DK / 64; ++i) pk[i] = __builtin_amdgcn_raw_buffer_load_b128(rs_ws, voffT, ks_ + (unsigned)(i * 8192), 0); \
        if (kind != 1 && tid < 64) pks = __builtin_bit_cast(float, __builtin_amdgcn_raw_buffer_load_b32(rs_ws, voffF, (unsigned)OFF_SK + sidx4_, 0)); \
        const unsigned vs_ = (unsigned)OFF_R0 + (unsigned)((h * 512 + vs * 128) * MTOK + row0_) * 2u; \
        _Pragma("unroll") for (int i = 0; i < 2; ++i) pv[i] = __builtin_amdgcn_raw_buffer_load_b128(rs_ws, voffV, vs_ + (unsigned)(i * 64 * MTOK * 2), 0); \
        ps = __builtin_amdgcn_raw_buffer_load_b128(rs_ws, voffT, (unsigned)OFF_RS + (unsigned)((dbh * 68 + c_) * 4096) * 2u, 0); \
        if (kind != 1 && tid < 64) pr = __builtin_bit_cast(float, __builtin_amdgcn_raw_buffer_load_b32(rs_ws, voffF, (unsigned)OFF_SR + sidx4_, 0)); \
        if (kind == 0 && tid < 64) { prs = __builtin_bit_cast(float, __builtin_amdgcn_raw_buffer_load_b32(rs_ws, voffF, (unsigned)OFF_RSUM + sidx4_, 0)); \
                                     pfl = __builtin_bit_cast(float, __builtin_amdgcn_raw_buffer_load_b32(rs_ws, voffF, (unsigned)OFF_SF + sidx4_, 0)); } \
        if (kind == 1 && tid < 128) pdec = __builtin_bit_cast(float, __builtin_amdgcn_raw_buffer_load_b32(rs_ws, voffF, (unsigned)OFF_DEC + (unsigned)((dbh * 68 + c_) * 128) * 4u, 0)); \
        if (kind != 1) pdsc = __builtin_bit_cast(float, __builtin_amdgcn_raw_buffer_load_b32(rs_ws, voffZ, (unsigned)OFF_DECS + (unsigned)(dbh * 68 + c_) * 4u, 0)); \
    } while (0)
    SCAN_ISSUE(s_lo);
    for (int s = s_lo; s < s_hi; ++s) {
        const int c = chunk_of(dir, s), row0 = b * LTOK + c * 64, par = s & 1;
        {
#pragma unroll
            for (int i = 0; i < DK / 64; ++i) { const int pi = tid + 512 * i, j = pi / (DK / 8), d8 = pi % (DK / 8);
                const int kk_ = d8 >> 2, u_ = d8 & 3, f_ = (u_ & 1) * 2, sub_ = u_ >> 1, rr_ = j & 15;
                lds_t qb_ = Ql + ((j >> 4) * (DK / 32) + kk_) * 1024 + sub_ * 8;
                *(LAS u32x2*)(qb_ + swz16x32(rr_ * 64 + f_ * 16)) = (u32x2){pq[i].x, pq[i].y};
                *(LAS u32x2*)(qb_ + swz16x32(rr_ * 64 + (f_ + 1) * 16)) = (u32x2){pq[i].z, pq[i].w}; }
            const int ks8_ = l8 >> 2, c8_ = l8 & 3;
#pragma unroll
            for (int i = 0; i < DK / 64; ++i) { const int pi = tid + 512 * i, d = pi >> 3;
                *(LAS u32x4*)(KTl + ((d >> 4) * 2 + ks8_) * 1024 + swz16x32((d & 15) * 64 + c8_ * 16)) = pk[i]; }
#pragma unroll
            for (int i = 0; i < 2; ++i) { const int pi = tid + 512 * i, vr = pi >> 3;
                *(LAS u32x4*)(VTl + ((vr >> 4) * 2 + ks8_) * 1024 + swz16x32((vr & 15) * 64 + c8_ * 16)) = pv[i]; }
            { const int j = tid >> 3; *(LAS u32x4*)(Sl + ((j >> 4) * 2 + ks8_) * 1024 + swz16x32((j & 15) * 64 + c8_ * 16)) = ps; }
            if (kind == 0 && tid < 64) { rsl[tid] = prs; fll[tid] = pfl; }
            if (kind != 1 && tid < 64) { rl[tid] = pks; rrl[tid] = pr; }
            if (kind == 0 && tid < 64) ((LAS bf16_t*)decl)[tid] = f2bf(pks);
            if (kind == 1 && tid < 128) decl[tid] = pdec;
        }
        const float dsc = pdsc;
        __syncthreads();
        u32x2 oo[4];
        if (s >= 36) {
#pragma unroll
            for (int rb = 0; rb < 4; ++rb) oo[rb] = __builtin_amdgcn_raw_buffer_load_b64(rs_ws, voffO, (unsigned)OFF_RO + (unsigned)((row0 + 16 * rb) * 2048 + h * 512 + vs * 128) * 2u, 0); }
        if (s + 1 < s_hi) SCAN_ISSUE(s + 1);
        if (kind == 0) {
            LAS unsigned char* nlb = (LAS unsigned char*)nl;
            { const int j = tid >> 3, part = tid & 7; float a = 0.f;
#pragma unroll
              for (int q = 0; q < 4; ++q) { const u32x4 v = *(const LAS u32x4*)(Ql + ((j >> 4) * (DK / 32) + part) * 1024 + swz16x32((j & 15) * 64 + q * 16));
                  const u32x4 nn = *(const LAS u32x4*)(nlb + par * 512 + (part * 32 + q * 8) * 2);
                  a = dot2(v.x, nn.x, a); a = dot2(v.y, nn.y, a); a = dot2(v.z, nn.z, a); a = dot2(v.w, nn.w, a); }
              a = DPP_ADD(a, 0xB1); a = DPP_ADD(a, 0x4E); a = DPP_ADD(a, 0x141);
              if (part == 0) qnl[j] = a; }
            if (tid < DK) { float sum = 0.f;
#pragma unroll
                for (int q = 0; q < 8; ++q) { const u32x4 v = *(const LAS u32x4*)(KTl + ((tid >> 4) * 2 + (q >> 2)) * 1024 + swz16x32((tid & 15) * 64 + (q & 3) * 16));
                    const u32x4 kk = *(const LAS u32x4*)((LAS unsigned char*)decl + q * 16);
                    sum = dot2(v.x, kk.x, sum); sum = dot2(v.y, kk.y, sum); sum = dot2(v.z, kk.z, sum); sum = dot2(v.w, kk.w, sum); }
                const int x_ = tid & 31, px_ = x_ < 16 ? 8 * (x_ >> 2) + (x_ & 3) : 8 * ((x_ - 16) >> 2) + 4 + (x_ & 3);
                S.nreg = dsc * S.nreg + sum; *(LAS bf16_t*)(nlb + (par ^ 1) * 512 + ((tid & ~31) + px_) * 2) = f2bf(S.nreg); }
        }
        f32x4 ax[4];
#pragma unroll
        for (int rb = 0; rb < 4; ++rb) ax[rb] = (f32x4){0.f, 0.f, 0.f, 0.f};
        u32x4 fa[2][4];
#define SCAN_LOADQ(slot, kk_) do { _Pragma("unroll") for (int rb = 0; rb < 4; ++rb) \
            fa[slot][rb] = *(const LAS u32x4*)(Ql + aoff + (rb * (DK / 32) + (kk_)) * 1024); } while (0)
#define SCAN_LOADS(slot, ks_) do { _Pragma("unroll") for (int rb = 0; rb < 4; ++rb) \
            fa[slot][rb] = *(const LAS u32x4*)(Sl + aoff + (rb * 2 + (ks_)) * 1024); } while (0)
#define SCAN_LOADK(slot, tp_) do { _Pragma("unroll") for (int q_ = 0; q_ < 4; ++q_) \
            fa[slot][q_] = *(const LAS u32x4*)(KTl + aoff + ((2 * (tp_) + (q_ >> 1)) * 2 + (q_ & 1)) * 1024); } while (0)
        constexpr int NKK = DK / 32;
        SCAN_LOADQ(0, 0);
        u32x4 swn;
        swn.x = pack2(S.st[0][0], S.st[0][1]); swn.y = pack2(S.st[0][2], S.st[0][3]); swn.z = pack2(S.st[1][0], S.st[1][1]); swn.w = pack2(S.st[1][2], S.st[1][3]);
#pragma unroll
        for (int kk = 0; kk < NKK; ++kk) {
            if (kk + 1 < NKK) SCAN_LOADQ((kk + 1) & 1, kk + 1); else SCAN_LOADS((kk + 1) & 1, 0);
            __builtin_amdgcn_sched_barrier(0);
            const bf16x8 sf = __builtin_bit_cast(bf16x8, swn);
#pragma unroll
            for (int rb = 0; rb < 4; ++rb) ax[rb] = MFMA16(sf, __builtin_bit_cast(bf16x8, fa[kk & 1][rb]), ax[rb]);
            if (kk + 1 < NKK) { swn.x = pack2(S.st[2 * kk + 2][0], S.st[2 * kk + 2][1]); swn.y = pack2(S.st[2 * kk + 2][2], S.st[2 * kk + 2][3]);
                                swn.z = pack2(S.st[2 * kk + 3][0], S.st[2 * kk + 3][1]); swn.w = pack2(S.st[2 * kk + 3][2], S.st[2 * kk + 3][3]); }
            __builtin_amdgcn_sched_barrier(0);
        }
        bf16x8 bv[2];
#pragma unroll
        for (int ks = 0; ks < 2; ++ks) bv[ks] = *(const LAS bf16x8*)(VTl + aoff + (wid * 2 + ks) * 1024);
        SCAN_LOADS((NKK + 1) & 1, 1);
        float rj[4] = {1.f, 1.f, 1.f, 1.f};
        if (kind != 1) {
#pragma unroll
            for (int rb = 0; rb < 4; ++rb) rj[rb] = rrl[16 * rb + fr]; }
        __builtin_amdgcn_sched_barrier(0);
        if (kind != 1) {
#pragma unroll
            for (int rb = 0; rb < 4; ++rb) ax[rb] = ax[rb] * rj[rb]; }
#pragma unroll
        for (int rb = 0; rb < 4; ++rb) ax[rb] = MFMA16(bv[0], __builtin_bit_cast(bf16x8, fa[NKK & 1][rb]), ax[rb]);
        __builtin_amdgcn_sched_barrier(0);
        SCAN_LOADK(NKK & 1, 0);
        __builtin_amdgcn_sched_barrier(0);
#pragma unroll
        for (int rb = 0; rb < 4; ++rb) ax[rb] = MFMA16(bv[1], __builtin_bit_cast(bf16x8, fa[(NKK + 1) & 1][rb]), ax[rb]);
        __builtin_amdgcn_sched_barrier(0);
        if (kind == 0) __syncthreads();
        const bool to_cb = (dir == 1) && (s < 4);
#pragma unroll
        for (int rb = 0; rb < 4; ++rb) { const int j = 16 * rb + fr;
            f32x4 v = ax[rb];
            { if (kind == 0) { const float den = rsl[j] + rj[rb] * qnl[j]; const float inv = __builtin_amdgcn_rcpf(fmaxf(fabsf(den), fll[j])); v = v * inv; } }
            const unsigned dsto = (to_cb ? (unsigned)OFF_OCB + (unsigned)((b * 256 + c * 64 + 16 * rb) * 2048) * 2u : (unsigned)OFF_RO + (unsigned)((row0 + 16 * rb) * 2048) * 2u) + (unsigned)(h * 512 + vs * 128) * 2u;
            if (s >= 36) { const u32x2 o = oo[rb]; v[0] += lo_f(o.x); v[1] += hi_f(o.x); v[2] += lo_f(o.y); v[3] += hi_f(o.y); }
            u32x2 w; w.x = pack2(v[0], v[1]); w.y = pack2(v[2], v[3]); __builtin_amdgcn_raw_buffer_store_b64(w, rs_ws, voffO, dsto, 0); }
        bf16x8 bvs[2];
#pragma unroll
        for (int ks = 0; ks < 2; ++ks) {
            if (kind != 1) { const f32x4 c0 = *(const LAS f32x4*)(rl + 32 * ks + 8 * fq), c1 = *(const LAS f32x4*)(rl + 32 * ks + 8 * fq + 4);
                const u32x4 v = __builtin_bit_cast(u32x4, bv[ks]); u32x4 w;
                w.x = pack2(lo_f(v.x) * c0[0], hi_f(v.x) * c0[1]); w.y = pack2(lo_f(v.y) * c0[2], hi_f(v.y) * c0[3]);
                w.z = pack2(lo_f(v.z) * c1[0], hi_f(v.z) * c1[1]); w.w = pack2(lo_f(v.w) * c1[2], hi_f(v.w) * c1[3]);
                bvs[ks] = __builtin_bit_cast(bf16x8, w); }
            else bvs[ks] = bv[ks];
        }
        __builtin_amdgcn_sched_barrier(0);
        constexpr int NTP = NT / 2;
        f32x4 dd[2][2];
        if (kind == 1) { dd[NKK & 1][0] = *(const LAS f32x4*)(decl + 4 * fq); dd[NKK & 1][1] = *(const LAS f32x4*)(decl + 16 + 4 * fq); }
#pragma unroll
        for (int tp = 0; tp < NTP; ++tp) {
            const int cur = (NKK + tp) & 1;
            if (tp + 1 < NTP) { SCAN_LOADK(cur ^ 1, tp + 1);
                if (kind == 1) { dd[cur ^ 1][0] = *(const LAS f32x4*)(decl + 16 * (2 * tp + 2) + 4 * fq); dd[cur ^ 1][1] = *(const LAS f32x4*)(decl + 16 * (2 * tp + 3) + 4 * fq); } }
            __builtin_amdgcn_sched_barrier(0);
#pragma unroll
            for (int u = 0; u < 2; ++u) { const int t = 2 * tp + u;
                f32x4 d4 = {dsc, dsc, dsc, dsc};
                if (kind == 1) d4 = dd[cur][u];
                f32x4 stv = S.st[t] * d4;
                stv = MFMA16(__builtin_bit_cast(bf16x8, fa[cur][2 * u]), bvs[0], stv);
                stv = MFMA16(__builtin_bit_cast(bf16x8, fa[cur][2 * u + 1]), bvs[1], stv);
                S.st[t] = stv; }
            __builtin_amdgcn_sched_barrier(0);
        }
#undef SCAN_LOADQ
#undef SCAN_LOADS
#undef SCAN_LOADK
        __syncthreads();
    }
}

template <int DK>
DI void phase_scan(const Params& p, lds_t lds, int kind) {
    const int G = gridDim.x, nround = (256 + G - 1) / G;
    for (int rd = 0; rd < nround; ++rd) {
        const int item = rd * G + blockIdx.x; const bool valid = item < 256;
        ScanState<DK> S;
#pragma unroll
        for (int t = 0; t < DK / 16; ++t) S.st[t] = (f32x4){0.f, 0.f, 0.f, 0.f};
        S.nreg = 0.f;
        if (valid) {
            LAS float* nl = (LAS float*)(lds + 64 * (DK * 2 + 16) + DK * 144 + 128 * 144 + 64 * 144) + 384;
            nl[otid()] = 0.f;
            __syncthreads();
            scan_steps<DK>(p, lds, kind, item, 0, 36, S);
        }
        xcd_barrier(p, lds);
        if (valid) scan_steps<DK>(p, lds, kind, item, 36, 68, S);
    }
}

DI void phase_p5(const Params& pin, int l, bool dummy) {
    const PP p = launder(pin);
    const int kind = lkind(l), lb = lbase(l);
    const int tid = otid(), wid = tid >> 6, lane = tid & 63;
    const float* hw = tin(p, lb + (kind == 0 ? 7 : (kind == 1 ? 6 : 5)));
    bf16_t* Og = (bf16_t*)(p.ws + OFF_RO); const bf16_t* Z = (const bf16_t*)(p.ws + OFF_R0); const bf16_t* OCB = (const bf16_t*)(p.ws + OFF_OCB);
    bf16_t* Yg = dummy ? (bf16_t*)(p.ws + OFF_RQ) : Og;
    const bool center = kind != 1;
    f32x4 hwv[4][2];
#pragma unroll
    for (int h = 0; h < 4; ++h) { hwv[h][0] = *(const f32x4*)(hw + h * 512 + lane * 8); hwv[h][1] = *(const f32x4*)(hw + h * 512 + lane * 8 + 4); }
    auto proc = [&](int row, const u32x4 (&ovv)[4], const u32x4 (&zvv)[4]) {
        const int b = row / LTOK, t = row - b * LTOK;
#pragma unroll
        for (int h = 0; h < 4; ++h) {
            const int col = h * 512 + lane * 8;
            const u32x4 ov = ovv[h];
            float o[8] = {lo_f(ov.x), hi_f(ov.x), lo_f(ov.y), hi_f(ov.y), lo_f(ov.z), hi_f(ov.z), lo_f(ov.w), hi_f(ov.w)};
            if (t < 256) { const u32x4 cv = *(const u32x4*)(OCB + (size_t)(b * 256 + t) * 2048 + col);
                o[0] += lo_f(cv.x); o[1] += hi_f(cv.x); o[2] += lo_f(cv.y); o[3] += hi_f(cv.y); o[4] += lo_f(cv.z); o[5] += hi_f(cv.z); o[6] += lo_f(cv.w); o[7] += hi_f(cv.w); }
            float mean = 0.f;
            if (center) { float sm = 0.f;
#pragma unroll
                for (int e = 0; e < 8; ++e) sm += o[e];
                mean = wsum(sm, lane) * (1.f / 512.f); }
            float q = 0.f;
#pragma unroll
            for (int e = 0; e < 8; ++e) { o[e] -= mean; q += o[e] * o[e]; }
            const float rstd = rsqrtf(wsum(q, lane) * (1.f / 512.f) + 1e-6f);
            const u32x4 zv = zvv[h];
            const float z[8] = {lo_f(zv.x), hi_f(zv.x), lo_f(zv.y), hi_f(zv.y), lo_f(zv.z), hi_f(zv.z), lo_f(zv.w), hi_f(zv.w)};
            const f32x4 w0 = hwv[h][0], w1 = hwv[h][1];
            float y[8];
#pragma unroll
            for (int e = 0; e < 8; ++e) y[e] = o[e] * rstd * (e < 4 ? w0[e] : w1[e - 4]) * siluf(z[e]);
            u32x4 w; w.x = pack2(y[0], y[1]); w.y = pack2(y[2], y[3]); w.z = pack2(y[4], y[5]); w.w = pack2(y[6], y[7]);
            *(u32x4*)(Yg + (size_t)row * 2048 + col) = w;
        }
    };
    const int stride = gridDim.x * 8;
    for (int rowa = blockIdx.x * 8 + wid; rowa < MTOK; rowa += 2 * stride) {
        const int rowb0 = rowa + stride; const bool hb = rowb0 < MTOK; const int rowb = hb ? rowb0 : rowa;
        u32x4 oa[4], za[4], ob[4], zb[4];
#pragma unroll
        for (int h = 0; h < 4; ++h) { const int col = h * 512 + lane * 8;
            oa[h] = *(const u32x4*)(Og + (size_t)rowa * 2048 + col); za[h] = *(const u32x4*)(Z + (size_t)rowa * 2048 + col);
            ob[h] = *(const u32x4*)(Og + (size_t)rowb * 2048 + col); zb[h] = *(const u32x4*)(Z + (size_t)rowb * 2048 + col); }
        proc(rowa, oa, za);
        if (hb) proc(rowb, ob, zb);
    }
}

DI void phase_final(const Params& pin) {
    const PP p = launder(pin);
    const int tid = otid(), wid = tid >> 6, lane = tid & 63;
    const float* nw = tin(p, 37);
    f32x4 nw4[4];
#pragma unroll
    for (int i = 0; i < 4; ++i) nw4[i] = *(const f32x4*)(nw + lane * 4 + 256 * i);
    const int stride = gridDim.x * 8, NR = 8 * 4096;
    for (int rowa = blockIdx.x * 8 + wid; rowa < NR; rowa += 2 * stride) {
        const int rowb0 = rowa + stride; const bool hb = rowb0 < NR; const int rowb = hb ? rowb0 : rowa;
        float* hpa = p.out + (size_t)rowa * 1024; float* hpb = p.out + (size_t)rowb * 1024;
        f32x4 xa[4], xb[4]; float sa = 0.f, sb = 0.f;
#pragma unroll
        for (int i = 0; i < 4; ++i) { xa[i] = *(const f32x4*)(hpa + lane * 4 + 256 * i); xb[i] = *(const f32x4*)(hpb + lane * 4 + 256 * i); }
#pragma unroll
        for (int i = 0; i < 4; ++i) { sa += xa[i][0] * xa[i][0] + xa[i][1] * xa[i][1] + xa[i][2] * xa[i][2] + xa[i][3] * xa[i][3]; sb += xb[i][0] * xb[i][0] + xb[i][1] * xb[i][1] + xb[i][2] * xb[i][2] + xb[i][3] * xb[i][3]; }
        sa = wsum(sa, lane); sb = wsum(sb, lane);
        const float ra = rsqrtf(sa * (1.f / 1024.f) + 1e-6f), rb = rsqrtf(sb * (1.f / 1024.f) + 1e-6f);
#pragma unroll
        for (int i = 0; i < 4; ++i) { *(f32x4*)(hpa + lane * 4 + 256 * i) = xa[i] * ra * nw4[i]; if (hb) *(f32x4*)(hpb + lane * 4 + 256 * i) = xb[i] * rb * nw4[i]; }
    }
}

__global__ void __launch_bounds__(512, 2) fwd_megakernel(Params p) {
    extern __shared__ __attribute__((aligned(16))) unsigned char shm[];
    lds_t lds = (lds_t)shm;
    cg::grid_group grid = cg::this_grid();
    const int G = gridDim.x, bid = blockIdx.x;
    volatile LAS unsigned* xst = (volatile LAS unsigned*)(lds + LDS_BYTES - 16);
    if (threadIdx.x == 0) { xst[0] = 0u; xst[1] = 0u; }
    __syncthreads();
    (void)xcd_barrier_post((unsigned*)(p.ws + OFF_BAR), xst);
    for (int rep = 0; rep < REP_P0; ++rep) phase0(p, lds);
    if (gridDim.x > 0x40000000u) grid.sync();
    xcd_barrier(p, lds);
    for (int l = 0; l < 4; ++l) {
        const int kind = lkind(l);
        const int nqk = kind == 1 ? 1024 : 2048;
        for (int rep = 0; rep < REP_P1F; ++rep) phase_p1(p, lds, l, true);
        xcd_barrier(p, lds);
        {
            if (kind == 0) { for (int it = (bid + G - 128 % G) % G; it < 32; it += G) mlstm_chain(p, lds, it >> 2, it & 3); }
            const PP q = launder(p); const bf16_t* WT = (const bf16_t*)(q.ws + off_wt(l));
            pg8::Gemm g{(const bf16_t*)(q.ws + OFF_RQ), WT, MTOK, nqk, 1024};
            pg8::StaticOrder S; S.init(g.M, g.N, G, bid);
            pg8::EpiBf16 E{(bf16_t*)(q.ws + OFF_RO), nqk};
            for (int rep = 0; rep < REP_GEMM; ++rep) pg8::gemm_phase(lds, g, S, E);
        }
        {
            const PP q = launder(p); const bf16_t* WT = (const bf16_t*)(q.ws + off_wt(l));
            pg8::Gemm g{WT + (size_t)nqk * 1024, (const bf16_t*)(q.ws + OFF_RQ), 2048, MTOK, 1024};
            pg8::StaticOrder S; S.init(g.M, g.N, G, (bid + G - (kind == 1 ? 128 : 64) % G) % G);
            pg8::EpiBf16 E{(bf16_t*)(q.ws + OFF_R0), MTOK};
            for (int rep = 0; rep < REP_GEMM; ++rep) pg8::gemm_phase(lds, g, S, E);
        }
        xcd_barrier(p, lds);
        for (int rep = 0; rep < REP_P3; ++rep) { if (kind == 0) phase_p3<256, 0>(p, lds, l); else if (kind == 1) phase_p3<128, 1>(p, lds, l); else phase_p3<256, 2>(p, lds, l); }
        xcd_barrier(p, lds);
        for (int rep = 0; rep < REP_SCAN; ++rep) { if (rep) xcd_barrier(p, lds); if (kind == 1) phase_scan<128>(p, lds, kind); else phase_scan<256>(p, lds, kind); }
        xcd_barrier(p, lds);
        for (int rep = 0; rep < REP_P1; ++rep) phase_p1(p, lds, l, false);
        xcd_barrier(p, lds);
        {
            const PP q = launder(p); const bf16_t* WT = (const bf16_t*)(q.ws + off_wt(l));
            pg8::Gemm g{(const bf16_t*)(q.ws + OFF_RQ), WT + (size_t)(nqk + 2048) * 1024, MTOK, 2048, 1024};
            pg8::StaticOrder S; S.init(g.M, g.N, G, bid, l == 3 ? 1 : 0);
#ifdef FUSE_GATE
            pg8::EpiGate E{(bf16_t*)(q.ws + OFF_RO), (const bf16_t*)(q.ws + OFF_OCB), (const f32x2*)(q.ws + OFF_STATS), tin(q, lbase(l) + (kind == 0 ? 7 : (kind == 1 ? 6 : 5)))};
            pg8::gemm_phase(lds, g, S, E);
        }
        xcd_barrier(p, lds);
#else
            pg8::EpiBf16 E{(bf16_t*)(q.ws + OFF_R0), 2048};
            pg8::gemm_phase(lds, g, S, E);
        }
        if (l < 3) weights_prep(p, lds, l + 1, G >= 128 ? 64 : 0);
        xcd_barrier(p, lds);
        for (int rep = 0; rep < REP_P5D; ++rep) phase_p5(p, l, true);
        phase_p5(p, l, false);
        xcd_barrier(p, lds);
#endif
        {
            const PP q = launder(p);
            pg8::Gemm g{(const bf16_t*)(q.ws + OFF_RO), (const bf16_t*)(q.ws + off_wo(l)), MTOK, 1024, 2048};
            pg8::StaticOrder S; S.init(g.M, g.N, G, bid, l == 3 ? 1 : 0);
            { pg8::EpiNull E0{(float*)(q.ws + OFF_STATS)}; for (int rep = 0; rep < REP_OUTD; ++rep) pg8::gemm_phase(lds, g, S, E0); }
            pg8::EpiRes E{q.out, (float*)(q.ws + OFF_HCTX), (const float*)(q.ws + OFF_ADA) + (size_t)l * 9 * 3072, l == 3 ? 1 : 0, l == 0 ? tin(q, 0) : nullptr, l == 0 ? tin(q, 2) : nullptr};
            pg8::gemm_phase(lds, g, S, E);
        }
        xcd_barrier(p, lds);
    }
    for (int rep = 0; rep < REP_SYNC; ++rep) xcd_barrier(p, lds);
    phase_final(p);
}

extern "C" void kernel_launch(void* const* d_in, const int* in_sizes, int n_in, void* d_out, int out_size, void* d_ws, size_t ws_size, hipStream_t stream) {
    static int grid = 0;
    if (grid == 0) {
        if (n_in != 38 || ws_size < WS_END) { fprintf(stderr, "kernel_launch: unexpected n_in %d or ws_size %zu (< %zu)\n", n_in, ws_size, (size_t)WS_END); grid = -1; return; }
        int dev = 0, cus = 0, per_cu = 0;
        hipGetDevice(&dev);
        hipDeviceGetAttribute(&cus, hipDeviceAttributeMultiprocessorCount, dev);
        if (hipFuncSetAttribute((const void*)fwd_megakernel, hipFuncAttributeMaxDynamicSharedMemorySize, LDS_BYTES) != hipSuccess) { fprintf(stderr, "hipFuncSetAttribute failed\n"); grid = -1; return; }
        hipOccupancyMaxActiveBlocksPerMultiprocessor(&per_cu, (const void*)fwd_megakernel, 512, LDS_BYTES);
        if (per_cu < 1) per_cu = 1;
        (void)hipGetLastError();
        grid = cus * per_cu;
        if (grid > 256) grid = 256;
    }
    if (grid < 0) return;
    (void)hipMemsetAsync((unsigned char*)d_ws + OFF_BAR, 0, 16384, stream);
    Params p{};
    for (int i = 0; i < 38; ++i) p.in[i] = (const float*)d_in[i];
    p.out = (float*)d_out; p.ws = (unsigned char*)d_ws;
    void* args[] = {&p};
    hipError_t e = hipLaunchCooperativeKernel((const void*)fwd_megakernel, dim3(grid), dim3(512), args, LDS_BYTES, stream);
    if (e != hipSuccess) fprintf(stderr, "cooperative launch failed: %s (grid %d)\n", hipGetErrorString(e), grid);
}
```
